# Optimizing an MI355X kernel written in HIP

```python
import jax, jax.numpy as jnp
from jax import lax
import numpy as np

D_MODEL = 1024
BATCH = 16
SEQ = 2048
DEPTH = 1

HEAD_DIM = 64
ROPE_THETA = 10000.0
NORM_EPS = 1e-6
NEG_INF = -1e30
BIG = 1e4
NSA_HEADS = 8
NSA_KV_HEADS = 2
NSA_GROUP = NSA_HEADS // NSA_KV_HEADS
CMP_BLOCK = 32
CMP_STRIDE = 16
CMP_HIDDEN = 256
SLC_BLOCK = 64
SLC_TOPN = 8
SLC_LOCAL = 2
WINDOW = 512
NSA_QCHUNK = 64
DSA_HEADS = 8
IDX_HEADS = 4
IDX_DIM = 64
DSA_TOPK_MAX = 256
DSA_QCHUNK = 128
D_FF = -(-8 * D_MODEL // (3 * 256)) * 256
IN_SPLIT = (
    NSA_HEADS * HEAD_DIM,
    NSA_KV_HEADS * HEAD_DIM,
    NSA_KV_HEADS * HEAD_DIM,
    NSA_KV_HEADS * HEAD_DIM,
    NSA_KV_HEADS * HEAD_DIM,
    NSA_KV_HEADS * HEAD_DIM,
    NSA_KV_HEADS * HEAD_DIM,
    3 * NSA_HEADS,
    DSA_HEADS * HEAD_DIM,
    HEAD_DIM,
    HEAD_DIM,
    IDX_HEADS * IDX_DIM,
    IDX_DIM,
    IDX_HEADS,
    2 * D_MODEL,
)
D_IN = sum(IN_SPLIT)

kernel_name = 'hybrid_nsa_dsa_gated_block'


def rmsnorm(x, g):
    xf = x.astype(jnp.float32)
    y = xf * lax.rsqrt(jnp.mean(xf * xf, axis=-1, keepdims=True) + NORM_EPS)
    return (y * g.astype(jnp.float32)).astype(x.dtype)


def rope(x, positions):
    half = x.shape[-1] // 2
    inv_freq = ROPE_THETA ** (-jnp.arange(half, dtype=jnp.float32) / half)
    ang = positions.astype(jnp.float32)[:, None] * inv_freq[None, :]
    cos = jnp.cos(ang)[None, :, None, :]
    sin = jnp.sin(ang)[None, :, None, :]
    xf = x.astype(jnp.float32)
    x1, x2 = xf[..., :half], xf[..., half:]
    return jnp.concatenate([x1 * cos - x2 * sin, x1 * sin + x2 * cos], axis=-1).astype(x.dtype)


def masked_softmax(s, mask):
    s = jnp.where(mask, s.astype(jnp.float32), NEG_INF)
    p = jax.nn.softmax(s, axis=-1)
    return p * jnp.any(mask, axis=-1, keepdims=True)


def to_chunks(a, size):
    b, s = a.shape[0], a.shape[1]
    return a.reshape(b, s // size, size, *a.shape[2:]).swapaxes(0, 1)


def from_chunks(a):
    a = a.swapaxes(0, 1)
    return a.reshape(a.shape[0], a.shape[1] * a.shape[2], *a.shape[3:])


def compress_tokens(kv, pos_emb, w1, w2):
    b, s, hk, d = kv.shape
    n_rep = CMP_BLOCK // CMP_STRIDE
    n_chunks = s // CMP_STRIDE
    ch = kv.reshape(b, n_chunks, CMP_STRIDE, hk, d)
    blocks = jnp.concatenate([ch[:, r:n_chunks - n_rep + 1 + r] for r in range(n_rep)], axis=2)
    blocks = blocks + pos_emb[None, None, :, None, :]
    flat = blocks.transpose(0, 1, 3, 2, 4).reshape(b, blocks.shape[1], hk, CMP_BLOCK * d)
    return jax.nn.gelu(flat @ w1) @ w2


def nsa_mixer(q, k_cmp, v_cmp, k_slc, v_slc, k_win, v_win, gates, pos_k, w1k, w2k, pos_v, w1v, w2v):
    b, s, h, d = q.shape
    scale = d ** -0.5
    qg = q.reshape(b, s, NSA_KV_HEADS, NSA_GROUP, d)
    t = jnp.arange(s)
    kc = compress_tokens(k_cmp, pos_k, w1k, w2k)
    vc = compress_tokens(v_cmp, pos_v, w1v, w2v)
    n_cmp = kc.shape[1]
    cmp_end = jnp.arange(n_cmp) * CMP_STRIDE + CMP_BLOCK - 1
    cmp_mask = (cmp_end[None, :] <= t[:, None])[None, :, None, None, :]
    p_cmp = masked_softmax(jnp.einsum('bshgd,bnhd->bshgn', qg, kc) * scale, cmp_mask)
    o_cmp = jnp.einsum('bshgn,bnhd->bshgd', p_cmp.astype(vc.dtype), vc)
    n_slc = s // SLC_BLOCK
    ci = jnp.arange(n_cmp)[:, None] * CMP_STRIDE
    sj = jnp.arange(n_slc)[None, :] * SLC_BLOCK
    overlap = ((ci < sj + SLC_BLOCK) & (ci + CMP_BLOCK > sj)).astype(jnp.float32)
    p_slc = jnp.einsum('bshn,nj->bshj', p_cmp.sum(axis=3), overlap)
    cur = (t // SLC_BLOCK)[:, None]
    j = jnp.arange(n_slc)[None, :]
    forced = (j == 0) | ((cur - j >= 0) & (cur - j < SLC_LOCAL))
    admissible = j <= cur
    blk_score = jnp.where(forced[None, :, None, :], BIG, p_slc)
    blk_score = jnp.where(admissible[None, :, None, :], blk_score, NEG_INF)
    n_sel = min(SLC_TOPN, n_slc)
    _, blk_idx = lax.top_k(blk_score, n_sel)
    kb = k_slc.reshape(b, n_slc, SLC_BLOCK, NSA_KV_HEADS, d).transpose(0, 3, 1, 2, 4)
    vb = v_slc.reshape(b, n_slc, SLC_BLOCK, NSA_KV_HEADS, d).transpose(0, 3, 1, 2, 4)
    k_win_pad = jnp.pad(k_win, ((0, 0), (WINDOW, 0), (0, 0), (0, 0)))
    v_win_pad = jnp.pad(v_win, ((0, 0), (WINDOW, 0), (0, 0), (0, 0)))
    bi = jnp.arange(b)[:, None, None, None]
    hi = jnp.arange(NSA_KV_HEADS)[None, None, :, None]
    n_tok = n_sel * SLC_BLOCK

    def chunk(args):
        q_c, idx_c, c = args
        t_c = c * NSA_QCHUNK + jnp.arange(NSA_QCHUNK)
        k_sel = kb[bi, hi, idx_c].reshape(b, NSA_QCHUNK, NSA_KV_HEADS, n_tok, d)
        v_sel = vb[bi, hi, idx_c].reshape(b, NSA_QCHUNK, NSA_KV_HEADS, n_tok, d)
        tok = (idx_c[..., None] * SLC_BLOCK + jnp.arange(SLC_BLOCK)).reshape(b, NSA_QCHUNK, NSA_KV_HEADS, n_tok)
        sel_mask = (tok <= t_c[None, :, None, None])[:, :, :, None, :]
        p = masked_softmax(jnp.einsum('bqhgd,bqhkd->bqhgk', q_c, k_sel) * scale, sel_mask)
        o_slc = jnp.einsum('bqhgk,bqhkd->bqhgd', p.astype(v_sel.dtype), v_sel)
        start = c * NSA_QCHUNK
        kwin = lax.dynamic_slice_in_dim(k_win_pad, start, WINDOW + NSA_QCHUNK, axis=1)
        vwin = lax.dynamic_slice_in_dim(v_win_pad, start, WINDOW + NSA_QCHUNK, axis=1)
        kpos = start - WINDOW + jnp.arange(WINDOW + NSA_QCHUNK)
        dist = t_c[:, None] - kpos[None, :]
        win_mask = ((kpos[None, :] >= 0) & (dist >= 0) & (dist < WINDOW))[None, :, None, None, :]
        p = masked_softmax(jnp.einsum('bqhgd,bkhd->bqhgk', q_c, kwin) * scale, win_mask)
        o_win = jnp.einsum('bqhgk,bkhd->bqhgd', p.astype(vwin.dtype), vwin)
        return o_slc, o_win

    n_chunk = s // NSA_QCHUNK
    o_slc, o_win = lax.map(chunk, (to_chunks(qg, NSA_QCHUNK), to_chunks(blk_idx, NSA_QCHUNK), jnp.arange(n_chunk)))
    g = jax.nn.sigmoid(gates.astype(jnp.float32)).astype(q.dtype).reshape(b, s, 3, NSA_KV_HEADS, NSA_GROUP)[..., None]
    o = g[:, :, 0] * o_cmp + g[:, :, 1] * from_chunks(o_slc) + g[:, :, 2] * from_chunks(o_win)
    return o.reshape(b, s, h * d)


def dsa_mixer(q, k, v, iq, ik, iw):
    b, s, h, d = q.shape
    scale = d ** -0.5
    topk = min(DSA_TOPK_MAX, s // 4)
    key_pos = jnp.arange(s)
    bi = jnp.arange(b)[:, None, None]

    def chunk(args):
        q_c, iq_c, iw_c, c = args
        t_c = c * DSA_QCHUNK + jnp.arange(DSA_QCHUNK)
        idx_logits = jnp.einsum('bqhd,bsd->bqhs', iq_c, ik).astype(jnp.float32) * IDX_DIM ** -0.5
        score = jnp.einsum('bqh,bqhs->bqs', iw_c.astype(jnp.float32), jax.nn.relu(idx_logits))
        score = jnp.where(key_pos[None, None, :] <= t_c[None, :, None], score, NEG_INF)
        _, sel = lax.top_k(score, topk)
        k_sel = k[bi, sel]
        v_sel = v[bi, sel]
        mask = (sel <= t_c[None, :, None])[:, :, None, :]
        p = masked_softmax(jnp.einsum('bqhd,bqkd->bqhk', q_c, k_sel) * scale, mask)
        return jnp.einsum('bqhk,bqkd->bqhd', p.astype(v_sel.dtype), v_sel)

    n_chunk = s // DSA_QCHUNK
    o = lax.map(chunk, (to_chunks(q, DSA_QCHUNK), to_chunks(iq, DSA_QCHUNK), to_chunks(iw, DSA_QCHUNK), jnp.arange(n_chunk)))
    return from_chunks(o).reshape(b, s, h * d)


def setup_inputs(seed: int = 0) -> dict:
    key = jax.random.key(seed)
    ks = jax.random.split(key, 17)
    f32 = jnp.float32

    def w(k, shape, fan_in):
        return jax.random.normal(k, shape, f32) * fan_in ** -0.5

    def gain(k, shape):
        return 1.0 + 0.05 * jax.random.normal(k, shape, f32)

    return {
        'x': jax.random.normal(ks[0], (BATCH, SEQ, D_MODEL), f32),
        'norm_mix': gain(ks[1], (DEPTH, D_MODEL)),
        'w_in': w(ks[2], (DEPTH, D_MODEL, D_IN), D_MODEL),
        'cmp_pos_k': 0.1 * jax.random.normal(ks[3], (DEPTH, CMP_BLOCK, HEAD_DIM), f32),
        'cmp_w1_k': w(ks[4], (DEPTH, CMP_BLOCK * HEAD_DIM, CMP_HIDDEN), CMP_BLOCK * HEAD_DIM),
        'cmp_w2_k': w(ks[5], (DEPTH, CMP_HIDDEN, HEAD_DIM), CMP_HIDDEN),
        'cmp_pos_v': 0.1 * jax.random.normal(ks[6], (DEPTH, CMP_BLOCK, HEAD_DIM), f32),
        'cmp_w1_v': w(ks[7], (DEPTH, CMP_BLOCK * HEAD_DIM, CMP_HIDDEN), CMP_BLOCK * HEAD_DIM),
        'cmp_w2_v': w(ks[8], (DEPTH, CMP_HIDDEN, HEAD_DIM), CMP_HIDDEN),
        'w_branch_nsa': w(ks[9], (DEPTH, NSA_HEADS * HEAD_DIM, D_MODEL), NSA_HEADS * HEAD_DIM),
        'w_branch_dsa': w(ks[10], (DEPTH, DSA_HEADS * HEAD_DIM, D_MODEL), DSA_HEADS * HEAD_DIM),
        'w_out': w(ks[11], (DEPTH, D_MODEL, D_MODEL), D_MODEL),
        'norm_ffn': gain(ks[12], (DEPTH, D_MODEL)),
        'w_gate': w(ks[13], (DEPTH, D_MODEL, D_FF), D_MODEL),
        'w_up': w(ks[14], (DEPTH, D_MODEL, D_FF), D_MODEL),
        'w_down': w(ks[15], (DEPTH, D_FF, D_MODEL), D_FF),
        'norm_final': gain(ks[16], (D_MODEL,)),
    }


def reference(x, norm_mix, w_in, cmp_pos_k, cmp_w1_k, cmp_w2_k, cmp_pos_v, cmp_w1_v, cmp_w2_v, w_branch_nsa, w_branch_dsa, w_out, norm_ffn, w_gate, w_up, w_down, norm_final):
    b, s, _ = x.shape
    positions = jnp.arange(s)
    offsets = np.cumsum(IN_SPLIT)[:-1].tolist()
    h = x
    for layer in range(DEPTH):
        xn = rmsnorm(h, norm_mix[layer])
        z = xn @ w_in[layer]
        (q_a, kc, vc, ksl, vsl, kwn, vwn, g_a, q_b, k_b, v_b, iq, ik, iw, g_merge) = jnp.split(z, offsets, axis=-1)
        kvh = lambda a: a.reshape(b, s, NSA_KV_HEADS, HEAD_DIM)
        q_a = rope(q_a.reshape(b, s, NSA_HEADS, HEAD_DIM), positions)
        kc = rope(kvh(kc), positions)
        ksl = rope(kvh(ksl), positions)
        kwn = rope(kvh(kwn), positions)
        y_a = nsa_mixer(q_a, kc, kvh(vc), ksl, kvh(vsl), kwn, kvh(vwn), g_a,
                        cmp_pos_k[layer], cmp_w1_k[layer], cmp_w2_k[layer],
                        cmp_pos_v[layer], cmp_w1_v[layer], cmp_w2_v[layer])
        q_b = rope(q_b.reshape(b, s, DSA_HEADS, HEAD_DIM), positions)
        k_b = rope(k_b.reshape(b, s, 1, HEAD_DIM), positions)[:, :, 0]
        iq = rope(iq.reshape(b, s, IDX_HEADS, IDX_DIM), positions)
        ik = rope(ik.reshape(b, s, 1, IDX_DIM), positions)[:, :, 0]
        iw = iw * IDX_HEADS ** -0.5
        y_b = dsa_mixer(q_b, k_b, v_b, iq, ik, iw)
        y_a = y_a @ w_branch_nsa[layer]
        y_b = y_b @ w_branch_dsa[layer]
        gate = jax.nn.sigmoid(g_merge.astype(jnp.float32)).astype(h.dtype)
        merged = gate[..., :D_MODEL] * y_a + gate[..., D_MODEL:] * y_b
        h = h + merged @ w_out[layer]
        hn = rmsnorm(h, norm_ffn[layer])
        h = h + (jax.nn.silu(hn @ w_gate[layer]) * (hn @ w_up[layer])) @ w_down[layer]
    return rmsnorm(h, norm_final)
```

```cpp
#include <hip/hip_runtime.h>
#include <hip/hip_cooperative_groups.h>
#include <cstdio>
#include <cstdint>
namespace cg = cooperative_groups;

#define LAS __attribute__((address_space(3)))
#define DI __device__ __forceinline__
typedef unsigned short bf16_t;
typedef short bf16x8 __attribute__((ext_vector_type(8)));
typedef short s16x4 __attribute__((ext_vector_type(4)));
typedef float f32x4 __attribute__((ext_vector_type(4)));
typedef float f32x2 __attribute__((ext_vector_type(2)));
typedef float f32x16 __attribute__((ext_vector_type(16)));
typedef unsigned u32x4 __attribute__((ext_vector_type(4)));
typedef unsigned u32x2 __attribute__((ext_vector_type(2)));

constexpr int BATCH = 16, SEQ = 2048, DM = 1024, MTOK = BATCH * SEQ;
constexpr int DIN = 4316, NZ = 4352, DFF = 2816, NGU = 2 * DFF;
constexpr float EPS = 1e-6f;
constexpr int ZC_QA = 0, ZC_KC = 512, ZC_KS = 640, ZC_KW = 768, ZC_QB = 896, ZC_KB = 1408, ZC_IQ = 1472, ZC_IK = 1728;
constexpr int ZC_VC = 1792, ZC_VS = 1920, ZC_VW = 2048, ZC_VB = 2176, ZC_GA = 2240, ZC_IW = 2264, ZC_GM = 2304;
constexpr size_t MiB = 1u << 20;
constexpr size_t WS_WIN = 0, WS_W1K = 9 * MiB, WS_W1V = 10 * MiB, WS_W2K = 11 * MiB, WS_W2V = 11 * MiB + 65536, WS_BIAS1 = 11 * MiB + 131072,
                 WS_ROPE = 11 * MiB + 524288, WS_WBA = 12 * MiB, WS_WBB = 13 * MiB, WS_WO = 14 * MiB, WS_WGU = 16 * MiB, WS_WD = 27 * MiB;
constexpr size_t WS_A = 34 * MiB;
constexpr size_t WS_XN = WS_A, WS_SC = WS_A, WS_T1 = WS_A, WS_MG = WS_A + 64 * MiB, WS_HB = WS_A + 128 * MiB;
constexpr size_t WS_Z = 226 * MiB, WS_ACT = WS_Z;
constexpr size_t WS_KCC = 498 * MiB, WS_VCT = 498 * MiB + 524288, WS_SS1 = 499 * MiB, WS_SS2 = 501 * MiB, WS_CTL = 503 * MiB, WS_END = 504 * MiB;
constexpr size_t OS_OCMP = 0, OS_YA = 32 * MiB, OS_YB = 64 * MiB, OS_DMASK = 96 * MiB, OS_SELM = 104 * MiB;

constexpr int NWAVES = 8, NTHR = 512;
constexpr int LDS_BYTES = 147456;

DI unsigned f2bf(float f) { unsigned u = __builtin_bit_cast(unsigned, f); return (u + 0x7fffu + ((u >> 16) & 1u)) >> 16; }
typedef __bf16 bf16x2_t __attribute__((ext_vector_type(2)));
DI unsigned pk2(float lo, float hi) { const f32x2 v = {lo, hi}; const bf16x2_t b = __builtin_convertvector(v, bf16x2_t); return __builtin_bit_cast(unsigned, b); }
DI float bf2f(unsigned short b) { return __builtin_bit_cast(float, (unsigned)b << 16); }
DI float bflo(unsigned w) { return __builtin_bit_cast(float, w << 16); }
DI float bfhi(unsigned w) { return __builtin_bit_cast(float, w & 0xffff0000u); }
DI float sigmoidf_(float x) { return __builtin_amdgcn_rcpf(1.0f + __expf(-x)); }
DI float wave_sum(float v) {
#pragma unroll
    for (int o = 1; o < 64; o <<= 1) v += __shfl_xor(v, o);
    return v;
}


#define XB_TMO      128
#define XB_XCNT(j)  (256  + 64 * (j))
#define XB_XSUB(j)  (1280 + 64 * (j))
#define XB_XGEN(j)  (2304 + 64 * (j))
#define XB_TOP      3328
#define XB_TOPGEN   3392
#define XCD_BAR_WORDS 3456
#define XB_SPIN_CAP (1u << 22)
DI unsigned xb_ld(unsigned* p)              { return __hip_atomic_load(p, __ATOMIC_RELAXED, __HIP_MEMORY_SCOPE_AGENT); }
DI unsigned xb_add(unsigned* p, unsigned v) { return __hip_atomic_fetch_add(p, v, __ATOMIC_RELAXED, __HIP_MEMORY_SCOPE_AGENT); }
DI unsigned xb_xcc_id() { return (unsigned)__builtin_amdgcn_s_getreg((3 << 11) | 20) & 0xFu; }
#define XB_SPIN(cond, bar) do { unsigned _sp = 0; while (cond) { __builtin_amdgcn_s_sleep(1); \
    if ((++_sp & 255u) == 0u) { if (xb_ld(&(bar)[XB_TMO])) break; if (_sp > XB_SPIN_CAP) { atomicAdd(&(bar)[XB_TMO], 1u); break; } } } } while (0)
struct XcdBarrier { unsigned* bar; unsigned x; volatile LAS unsigned* st; };
DI XcdBarrier xcd_barrier_post(unsigned* bar, volatile LAS unsigned* st) {
    XcdBarrier b; b.bar = bar; b.x = xb_xcc_id(); b.st = st;
    if (threadIdx.x == 0) (void)xb_add(&bar[XB_XCNT(b.x)], 1u);
    return b;
}
DI void xcd_barrier_complete(unsigned* bar, unsigned x, unsigned& nloc, unsigned& nx) {
    const unsigned G = gridDim.x * gridDim.y * gridDim.z;
    unsigned sum, cnt, mine, sp = 0u;
    for (;;) {
        sum = 0u; cnt = 0u; mine = 0u;
#pragma unroll
        for (unsigned j = 0; j < 16; ++j) { const unsigned c = xb_ld(&bar[XB_XCNT(j)]); sum += c; cnt += (c > 0u) ? 1u : 0u; mine = (j == x) ? c : mine; }
        if (sum == G) break;
        __builtin_amdgcn_s_sleep(1);
        if ((++sp & 255u) == 0u) { if (xb_ld(&bar[XB_TMO])) break; if (sp > XB_SPIN_CAP) { atomicAdd(&bar[XB_TMO], 1u); break; } }
    }
    nloc = mine > 0u ? mine : 1u; nx = cnt > 0u ? cnt : 1u;
}
DI void xcd_barrier(const XcdBarrier& b) {
    asm volatile("s_waitcnt vmcnt(0)" ::: "memory");
    __syncthreads();
    if (threadIdx.x == 0) {
        unsigned* bar = b.bar;
        __builtin_amdgcn_s_waitcnt(0);
        unsigned nloc = b.st[0], nx = b.st[1];
        if (nloc == 0u) { xcd_barrier_complete(bar, b.x, nloc, nx); b.st[0] = nloc; b.st[1] = nx; }
        const unsigned old = xb_add(&bar[XB_XSUB(b.x)], 1u);
        const unsigned gen = old / nloc;
        if (old + 1u == (gen + 1u) * nloc) {
            __builtin_amdgcn_fence(__ATOMIC_RELEASE, "agent");
            asm volatile("s_waitcnt vmcnt(0)" ::: "memory");
            const unsigned og = xb_add(&bar[XB_TOP], 1u);
            const unsigned tg = og / nx;
            if (og + 1u == (tg + 1u) * nx) xb_add(&bar[XB_TOPGEN], 1u);
            else XB_SPIN(xb_ld(&bar[XB_TOPGEN]) == tg, bar);
            __builtin_amdgcn_fence(__ATOMIC_ACQUIRE, "agent");
            xb_add(&bar[XB_XGEN(b.x)], 1u);
            asm volatile("s_waitcnt vmcnt(0)" ::: "memory");
        } else {
            XB_SPIN(xb_ld(&bar[XB_XGEN(b.x)]) == gen, bar);
            __builtin_amdgcn_fence(__ATOMIC_ACQUIRE, "agent");
            asm volatile("s_waitcnt vmcnt(0)" ::: "memory");
        }
    }
    __syncthreads();
}

namespace pg8 {
constexpr int BM = 256, BK = 64, HALF = 128, HTB = HALF * BK * 2, STAGE_BYTES = 8 * HTB, NXCD = 8, WGM = 8;
DI int lds_byte(int r, int c) { const int st = (r >> 4) * 2 + (c >> 5), rr = r & 15, cc = c & 31, ob = rr * 64 + cc * 2; return st * 1024 + (ob ^ (((ob >> 9) & 1) << 5)); }
DI void stage_rc(int b, int& R, int& C) { const int st = b / 1024, sb = b % 1024, swz = sb ^ (((sb >> 9) & 1) << 5); R = (st >> 1) * 16 + swz / 64; C = (st & 1) * 32 + (swz % 64) / 2; }
DI int perm32(int rho) { const int n = rho >> 4, i = rho & 15; return 8 * (i >> 2) + 4 * n + (i & 3); }
struct Unit { int pm, pn; };
struct Gemm { const bf16_t* A; const bf16_t* Bt; int M, N, K; };
struct StaticOrder {
    int nM, nN, nwg, G, c;
    DI void init(int M, int N, int G_, int c_) { nM = M / BM; nN = N / BM; nwg = nM * nN; G = G_; c = c_; }
    DI bool next(int i, Unit& u) const {
        const long L = (long)i * G + c; if (L >= nwg) return false;
        int wgid = (int)L; { const int q = nwg / NXCD, r = nwg % NXCD, xcd = wgid % NXCD, off = wgid / NXCD; wgid = (xcd < r ? xcd * (q + 1) : r * (q + 1) + (xcd - r) * q) + off; }
        const int nig = WGM * nN, gid = wgid / nig, fm = gid * WGM, gsz = (nM - fm) < WGM ? (nM - fm) : WGM;
        u.pm = fm + ((wgid % nig) % gsz); u.pn = (wgid % nig) / gsz; return true;
    }
};
template <class Epi, bool HOOK = false>
DI void gemm_phase(LAS unsigned char* lds, const Gemm g, const StaticOrder& S, const Epi& E) {
    int tid = threadIdx.x; asm volatile("" : "+v"(tid));
    const int wid = __builtin_amdgcn_readfirstlane(tid >> 6), lane = tid & 63, wr = wid >> 2, wc = wid & 3, fr = lane & 15, fq = lane >> 4;
    const int K = g.K, nt = K / BK;
    unsigned voffA[2], voffB[2];
#pragma unroll
    for (int i = 0; i < 2; ++i) { int R, C; stage_rc(tid * 16 + i * 8192, R, C); const int Rb = (R & ~31) + perm32(R & 31);
        voffA[i] = (unsigned)(R * K + C) * 2u; voffB[i] = (unsigned)(Rb * K + C) * 2u; }
    const size_t kstep = (size_t)(BK * 2);
    const size_t hstep = (size_t)HALF * K * 2;
    const size_t tstep = 2 * hstep;
    const unsigned ldsw = (unsigned)wid * 1024u;
    const int aoff = lds_byte(wr * 64 + fr, fq * 8), boff = lds_byte(wc * 32 + fr, fq * 8);
#define PG8_SA(b, h) (((b) * 2 + (h)) * HTB)
#define PG8_SB(b, h) ((4 + (b) * 2 + (h)) * HTB)
#define PG8_STAGE(bufoff, gbase, voff) do { _Pragma("unroll") for (int _i = 0; _i < 2; ++_i) \
        __builtin_amdgcn_global_load_lds((const unsigned*)((const char*)(gbase) + (voff)[_i]), (LAS unsigned*)(lds + (bufoff) + ldsw + _i * 8192), 16, 0, 0); } while (0)
#define PG8_LDA(dst, b, h) do { _Pragma("unroll") for (int m = 0; m < 4; ++m) _Pragma("unroll") for (int k = 0; k < 2; ++k) dst[m][k] = *(const LAS bf16x8*)(lds + PG8_SA(b, h) + aoff + m * 2048 + k * 1024); } while (0)
#define PG8_LDB(dst, b, h) do { _Pragma("unroll") for (int n = 0; n < 2; ++n) _Pragma("unroll") for (int k = 0; k < 2; ++k) dst[n][k] = *(const LAS bf16x8*)(lds + PG8_SB(b, h) + boff + n * 2048 + k * 1024); } while (0)
#define PG8_MMA(ai, bj, At, Bt) do { __builtin_amdgcn_s_setprio(1); _Pragma("unroll") for (int m = 0; m < 4; ++m) _Pragma("unroll") for (int n = 0; n < 2; ++n) _Pragma("unroll") for (int k = 0; k < 2; ++k) \
        acc[ai][bj][m][n] = __builtin_amdgcn_mfma_f32_16x16x32_bf16(Bt[n][k], At[m][k], acc[ai][bj][m][n], 0, 0, 0); __builtin_amdgcn_s_setprio(0); } while (0)
#define PG8_WAIT_V(n) asm volatile("s_waitcnt vmcnt(" #n ")" ::: "memory")
#define PG8_WAIT_L(n) asm volatile("s_waitcnt lgkmcnt(" #n ")" ::: "memory")
#define PG8_BAR __builtin_amdgcn_s_barrier()
#define PG8_SCHED __builtin_amdgcn_sched_barrier(0)
    Unit cur, nxt; int ui = 0;
    if (!S.next(0, cur)) return;
    f32x4 acc[2][2][4][2];
#pragma unroll
    for (int a = 0; a < 2; ++a)
#pragma unroll
        for (int b = 0; b < 2; ++b)
#pragma unroll
            for (int m = 0; m < 4; ++m)
#pragma unroll
                for (int n = 0; n < 2; ++n) acc[a][b][m][n] = (f32x4){0.f, 0.f, 0.f, 0.f};
    bf16x8 At[4][2], B0[2][2], B1[2][2];
    const char* cA = (const char*)g.A + (size_t)cur.pm * tstep; const char* cB = (const char*)g.Bt + (size_t)cur.pn * tstep;
    PG8_STAGE(PG8_SB(0, 0), cB, voffB); PG8_STAGE(PG8_SB(0, 1), cB + hstep, voffB); PG8_STAGE(PG8_SA(0, 0), cA, voffA); PG8_STAGE(PG8_SA(0, 1), cA + hstep, voffA);
    if (wr == 1) PG8_BAR;
    PG8_WAIT_V(2); PG8_BAR;
    PG8_STAGE(PG8_SB(1, 0), cB + kstep, voffB); PG8_STAGE(PG8_SA(1, 0), cA + kstep, voffA); PG8_STAGE(PG8_SB(1, 1), cB + hstep + kstep, voffB);
    PG8_WAIT_V(6); PG8_BAR;
    for (;;) {
        const bool has_next = S.next(ui + 1, nxt);
        const char* nA = has_next ? (const char*)g.A + (size_t)nxt.pm * tstep : cA; const char* nB = has_next ? (const char*)g.Bt + (size_t)nxt.pn * tstep : cB;
#define PG8_KBODY() do { \
            const bool last = (t == nt - 2); \
            const char* a1 = cA + (size_t)(t + 1) * kstep; \
            const char* a2 = last ? nA : cA + (size_t)(t + 2) * kstep; const char* b2 = last ? nB : cB + (size_t)(t + 2) * kstep; \
            const char* a3 = a2 + kstep; const char* b3 = b2 + kstep; \
            PG8_LDB(B0, 0, 0); PG8_LDB(B1, 0, 1); PG8_SCHED; PG8_LDA(At, 0, 0); PG8_STAGE(PG8_SA(1, 1), a1 + hstep, voffA); \
            PG8_WAIT_V(8); PG8_WAIT_L(0); PG8_BAR; PG8_MMA(0, 0, At, B0); PG8_MMA(0, 1, At, B1); PG8_BAR; PG8_SCHED; \
            PG8_LDA(At, 0, 1); PG8_STAGE(PG8_SB(0, 0), b2, voffB); PG8_STAGE(PG8_SB(0, 1), b2 + hstep, voffB); PG8_STAGE(PG8_SA(0, 0), a2, voffA); \
            PG8_WAIT_V(8); PG8_WAIT_L(0); PG8_BAR; PG8_MMA(1, 0, At, B0); PG8_MMA(1, 1, At, B1); PG8_BAR; PG8_SCHED; \
            PG8_LDB(B0, 1, 0); PG8_LDB(B1, 1, 1); PG8_SCHED; PG8_LDA(At, 1, 0); PG8_STAGE(PG8_SA(0, 1), a2 + hstep, voffA); \
            PG8_WAIT_V(8); PG8_WAIT_L(0); PG8_BAR; PG8_MMA(0, 0, At, B0); PG8_MMA(0, 1, At, B1); PG8_BAR; PG8_SCHED; \
            PG8_LDA(At, 1, 1); PG8_STAGE(PG8_SB(1, 0), b3, voffB); PG8_STAGE(PG8_SB(1, 1), b3 + hstep, voffB); PG8_STAGE(PG8_SA(1, 0), a3, voffA); \
            PG8_WAIT_V(8); PG8_WAIT_L(0); PG8_BAR; PG8_MMA(1, 0, At, B0); PG8_MMA(1, 1, At, B1); PG8_BAR; PG8_SCHED; \
        } while (0)
        if constexpr (HOOK) {
            for (int t = 0; t < (nt >> 1); t += 2) PG8_KBODY();
            E.hook(acc, cur, wr, wc, fr, fq);
            for (int t = (nt >> 1); t < nt; t += 2) PG8_KBODY();
        } else {
            for (int t = 0; t < nt; t += 2) PG8_KBODY();
        }
#undef PG8_KBODY
        if (wr == 0) PG8_BAR;
        E(acc, cur, wr, wc, fr, fq);
        if (!has_next) break;
#pragma unroll
        for (int a = 0; a < 2; ++a)
#pragma unroll
            for (int b = 0; b < 2; ++b)
#pragma unroll
                for (int m = 0; m < 4; ++m)
#pragma unroll
                    for (int n = 0; n < 2; ++n) acc[a][b][m][n] = (f32x4){0.f, 0.f, 0.f, 0.f};
        cur = nxt; cA = nA; cB = nB; ++ui;
        if (wr == 1) PG8_BAR;
    }
    PG8_WAIT_V(0);
    PG8_BAR;
#undef PG8_SA
#undef PG8_SB
#undef PG8_STAGE
#undef PG8_LDA
#undef PG8_LDB
#undef PG8_MMA
#undef PG8_WAIT_V
#undef PG8_WAIT_L
#undef PG8_BAR
#undef PG8_SCHED
}
}
using pg8::Unit;
typedef f32x4 Acc[2][2][4][2];

struct EpiInProj {
    bf16_t* Z; const float* ropec; const float* ropes;
    DI void operator()(const Acc& acc, const Unit& u, int wr, int wc, int fr, int fq) const {
        const int row0 = u.pm * 256 + wr * 64 + fr;
        if (u.pn < 7) {
            const int jj = 16 * (wc & 1) + 4 * fq;
#pragma unroll
            for (int ai = 0; ai < 2; ++ai)
#pragma unroll
                for (int m = 0; m < 4; ++m) {
                    const int r = row0 + ai * 128 + m * 16; const int pos = r & (SEQ - 1);
                    const f32x4 c = *(const f32x4*)(ropec + pos * 32 + jj), s = *(const f32x4*)(ropes + pos * 32 + jj);
#pragma unroll
                    for (int bj = 0; bj < 2; ++bj) {
                        const f32x4 x1 = acc[ai][bj][m][0], x2 = acc[ai][bj][m][1];
                        const f32x4 o1 = x1 * c - x2 * s, o2 = x1 * s + x2 * c;
                        bf16_t* p = Z + (size_t)r * NZ + u.pn * 256 + bj * 128 + (wc >> 1) * 64 + jj;
                        u32x2 w1; w1.x = pk2(o1[0], o1[1]); w1.y = pk2(o1[2], o1[3]);
                        u32x2 w2; w2.x = pk2(o2[0], o2[1]); w2.y = pk2(o2[2], o2[3]);
                        *(u32x2*)p = w1; *(u32x2*)(p + 32) = w2;
                    }
                }
        } else {
#pragma unroll
            for (int ai = 0; ai < 2; ++ai)
#pragma unroll
                for (int m = 0; m < 4; ++m) {
                    const int r = row0 + ai * 128 + m * 16;
#pragma unroll
                    for (int bj = 0; bj < 2; ++bj) {
                        const f32x4 v0 = acc[ai][bj][m][0], v1 = acc[ai][bj][m][1];
                        u32x4 w; w.x = pk2(v0[0], v0[1]); w.y = pk2(v0[2], v0[3]); w.z = pk2(v1[0], v1[1]); w.w = pk2(v1[2], v1[3]);
                        *(u32x4*)(Z + (size_t)r * NZ + u.pn * 256 + bj * 128 + wc * 32 + 8 * fq) = w;
                    }
                }
        }
    }
};
template <int SECOND> struct EpiGate {
    const bf16_t* Z; bf16_t* T1; bf16_t* MG;
    DI void operator()(const Acc& acc, const Unit& u, int wr, int wc, int fr, int fq) const {
        const int row0 = u.pm * 256 + wr * 64 + fr;
#pragma unroll
        for (int ai = 0; ai < 2; ++ai)
#pragma unroll
            for (int m = 0; m < 4; ++m) {
                const int r = row0 + ai * 128 + m * 16;
#pragma unroll
                for (int bj = 0; bj < 2; ++bj) {
                    const int c0 = u.pn * 256 + bj * 128 + wc * 32 + 8 * fq;
                    const u32x4 gw = *(const u32x4*)(Z + (size_t)r * NZ + ZC_GM + SECOND * DM + c0);
                    const f32x4 v0 = acc[ai][bj][m][0], v1 = acc[ai][bj][m][1];
                    float o[8];
                    o[0] = v0[0] * sigmoidf_(bflo(gw.x)); o[1] = v0[1] * sigmoidf_(bfhi(gw.x)); o[2] = v0[2] * sigmoidf_(bflo(gw.y)); o[3] = v0[3] * sigmoidf_(bfhi(gw.y));
                    o[4] = v1[0] * sigmoidf_(bflo(gw.z)); o[5] = v1[1] * sigmoidf_(bfhi(gw.z)); o[6] = v1[2] * sigmoidf_(bflo(gw.w)); o[7] = v1[3] * sigmoidf_(bfhi(gw.w));
                    if (SECOND) {
                        const u32x4 t = *(const u32x4*)(T1 + (size_t)r * DM + c0);
                        o[0] += bflo(t.x); o[1] += bfhi(t.x); o[2] += bflo(t.y); o[3] += bfhi(t.y); o[4] += bflo(t.z); o[5] += bfhi(t.z); o[6] += bflo(t.w); o[7] += bfhi(t.w);
                    }
                    u32x4 w; w.x = pk2(o[0], o[1]); w.y = pk2(o[2], o[3]); w.z = pk2(o[4], o[5]); w.w = pk2(o[6], o[7]);
                    *(u32x4*)((SECOND ? MG : T1) + (size_t)r * DM + c0) = w;
                }
            }
    }
};
struct EpiMerge {
    const bf16_t* Z; bf16_t* MG;
    DI void hook(Acc& acc, const Unit& u, int wr, int wc, int fr, int fq) const {
        const int row0 = u.pm * 256 + wr * 64 + fr;
#pragma unroll
        for (int ai = 0; ai < 2; ++ai)
#pragma unroll
            for (int m = 0; m < 4; ++m) {
                const int r = row0 + ai * 128 + m * 16;
#pragma unroll
                for (int bj = 0; bj < 2; ++bj) {
                    const int c0 = u.pn * 256 + bj * 128 + wc * 32 + 8 * fq;
                    const u32x4 ga = *(const u32x4*)(Z + (size_t)r * NZ + ZC_GM + c0), gb = *(const u32x4*)(Z + (size_t)r * NZ + ZC_GM + DM + c0);
                    float ra[8];
                    const unsigned gaw[4] = {ga.x, ga.y, ga.z, ga.w}, gbw[4] = {gb.x, gb.y, gb.z, gb.w};
#pragma unroll
                    for (int q = 0; q < 4; ++q) {
                        ra[2 * q] = (1.0f + __expf(-bflo(gbw[q]))) * __builtin_amdgcn_rcpf(1.0f + __expf(-bflo(gaw[q])));
                        ra[2 * q + 1] = (1.0f + __expf(-bfhi(gbw[q]))) * __builtin_amdgcn_rcpf(1.0f + __expf(-bfhi(gaw[q])));
                    }
                    acc[ai][bj][m][0] = acc[ai][bj][m][0] * (f32x4){ra[0], ra[1], ra[2], ra[3]};
                    acc[ai][bj][m][1] = acc[ai][bj][m][1] * (f32x4){ra[4], ra[5], ra[6], ra[7]};
                }
                asm volatile("" ::: "memory");
            }
    }
    DI void operator()(const Acc& acc, const Unit& u, int wr, int wc, int fr, int fq) const {
        int row0 = u.pm * 256 + wr * 64 + fr; asm volatile("" : "+v"(row0));
#pragma unroll
        for (int ai = 0; ai < 2; ++ai)
#pragma unroll
            for (int m = 0; m < 4; ++m) {
                const int r = row0 + ai * 128 + m * 16;
#pragma unroll
                for (int bj = 0; bj < 2; ++bj) {
                    const int c0 = u.pn * 256 + bj * 128 + wc * 32 + 8 * fq;
                    const u32x4 gw = *(const u32x4*)(Z + (size_t)r * NZ + ZC_GM + DM + c0);
                    const f32x4 v0 = acc[ai][bj][m][0], v1 = acc[ai][bj][m][1];
                    u32x4 w;
                    w.x = pk2(v0[0] * sigmoidf_(bflo(gw.x)), v0[1] * sigmoidf_(bfhi(gw.x))); w.y = pk2(v0[2] * sigmoidf_(bflo(gw.y)), v0[3] * sigmoidf_(bfhi(gw.y)));
                    w.z = pk2(v1[0] * sigmoidf_(bflo(gw.z)), v1[1] * sigmoidf_(bfhi(gw.z))); w.w = pk2(v1[2] * sigmoidf_(bflo(gw.w)), v1[3] * sigmoidf_(bfhi(gw.w)));
                    *(u32x4*)(MG + (size_t)r * DM + c0) = w;
                }
            }
    }
};
template <int MODE> struct EpiResid {
    const float* base; const bf16_t* baseb; float* H; bf16_t* HB; float* SS;
    DI void operator()(const Acc& acc, const Unit& u, int wr, int wc, int fr, int fq) const {
        const int row0 = u.pm * 256 + wr * 64 + fr;
#pragma unroll
        for (int ai = 0; ai < 2; ++ai)
#pragma unroll
            for (int m = 0; m < 4; ++m) {
                const int r = row0 + ai * 128 + m * 16; float ss = 0.f;
#pragma unroll
                for (int bj = 0; bj < 2; ++bj) {
                    const int c0 = u.pn * 256 + bj * 128 + wc * 32 + 8 * fq; const size_t off = (size_t)r * DM + c0;
                    f32x4 b0, b1;
                    if (MODE == 1) { b0 = *(const f32x4*)(base + off); b1 = *(const f32x4*)(base + off + 4); }
                    else { const u32x4 w = *(const u32x4*)(baseb + off); b0 = (f32x4){bflo(w.x), bfhi(w.x), bflo(w.y), bfhi(w.y)}; b1 = (f32x4){bflo(w.z), bfhi(w.z), bflo(w.w), bfhi(w.w)}; }
                    const f32x4 h0 = b0 + acc[ai][bj][m][0], h1 = b1 + acc[ai][bj][m][1];
                    ss += (h0[0] * h0[0] + h0[1] * h0[1]) + (h0[2] * h0[2] + h0[3] * h0[3]) + (h1[0] * h1[0] + h1[1] * h1[1]) + (h1[2] * h1[2] + h1[3] * h1[3]);
                    if (MODE == 1) { u32x4 w; w.x = pk2(h0[0], h0[1]); w.y = pk2(h0[2], h0[3]); w.z = pk2(h1[0], h1[1]); w.w = pk2(h1[2], h1[3]); *(u32x4*)(HB + off) = w; }
                    else { u32x4 w; w.x = pk2(h0[0], h0[1]); w.y = pk2(h0[2], h0[3]); w.z = pk2(h1[0], h1[1]); w.w = pk2(h1[2], h1[3]); *(u32x4*)(HB + off) = w; }
                }
                ss += __shfl_xor(ss, 16); ss += __shfl_xor(ss, 32);
                if (fq == 0) SS[(size_t)r * 16 + u.pn * 4 + wc] = ss;
            }
    }
};
struct EpiDownNorm {
    const bf16_t* baseb; float* OUT; const float* gfin; unsigned* xslot; unsigned* cnt; LAS unsigned char* ldsx;
    DI void operator()(Acc& acc, const Unit& u, int wr, int wc, int fr, int fq) const {
        const int lane = fr + 16 * fq, wid = wr * 4 + wc, tid = wid * 64 + lane;
        LAS float* P = (LAS float*)ldsx;
        LAS float* S = (LAS float*)(ldsx + 4096);
        const int rl0 = wr * 64 + fr;
#pragma unroll
        for (int ai = 0; ai < 2; ++ai)
#pragma unroll
            for (int m = 0; m < 4; ++m) {
                const int rl = rl0 + ai * 128 + m * 16; const int r = u.pm * 256 + rl; float ss = 0.f;
#pragma unroll
                for (int bj = 0; bj < 2; ++bj) {
                    const int c0 = u.pn * 256 + bj * 128 + wc * 32 + 8 * fq;
                    const u32x4 w = *(const u32x4*)(baseb + (size_t)r * DM + c0);
                    const f32x4 h0 = (f32x4){bflo(w.x), bfhi(w.x), bflo(w.y), bfhi(w.y)} + acc[ai][bj][m][0], h1 = (f32x4){bflo(w.z), bfhi(w.z), bflo(w.w), bfhi(w.w)} + acc[ai][bj][m][1];
                    acc[ai][bj][m][0] = h0; acc[ai][bj][m][1] = h1;
                    ss += (h0[0] * h0[0] + h0[1] * h0[1]) + (h0[2] * h0[2] + h0[3] * h0[3]) + (h1[0] * h1[0] + h1[1] * h1[1]) + (h1[2] * h1[2] + h1[3] * h1[3]);
                }
                ss += __shfl_xor(ss, 16); ss += __shfl_xor(ss, 32);
                if (fq == 0) P[rl * 4 + wc] = ss;
            }
        asm volatile("s_waitcnt lgkmcnt(0)" ::: "memory"); __builtin_amdgcn_s_barrier(); asm volatile("" ::: "memory");
        if (tid < 256) {
            const float s = (P[tid * 4 + 0] + P[tid * 4 + 1]) + (P[tid * 4 + 2] + P[tid * 4 + 3]);
            __hip_atomic_store(xslot + (size_t)(u.pm * 256 + tid) * 4 + u.pn, __builtin_bit_cast(unsigned, s), __ATOMIC_RELAXED, __HIP_MEMORY_SCOPE_AGENT);
        }
        asm volatile("s_waitcnt vmcnt(0)" ::: "memory");
        if (lane == 0) __hip_atomic_fetch_add(cnt + 64 * u.pm, 1u, __ATOMIC_RELAXED, __HIP_MEMORY_SCOPE_AGENT);
        if (wid == 0) {
            unsigned sp = 0;
            while ((unsigned)__builtin_amdgcn_readfirstlane(__hip_atomic_load(cnt + 64 * u.pm, __ATOMIC_RELAXED, __HIP_MEMORY_SCOPE_AGENT)) < 32u) { __builtin_amdgcn_s_sleep(2); if (++sp > (1u << 22)) break; }
        }
        asm volatile("s_waitcnt vmcnt(0) lgkmcnt(0)" ::: "memory"); __builtin_amdgcn_s_barrier(); asm volatile("" ::: "memory");
        if (tid < 256) {
            const unsigned* sl = xslot + (size_t)(u.pm * 256 + tid) * 4; float tot = 0.f;
#pragma unroll
            for (int t = 0; t < 4; ++t) tot += __builtin_bit_cast(float, __hip_atomic_load(sl + t, __ATOMIC_RELAXED, __HIP_MEMORY_SCOPE_AGENT));
            S[tid] = 1.0f / sqrtf(tot * (1.0f / DM) + EPS);
        }
        asm volatile("s_waitcnt vmcnt(0) lgkmcnt(0)" ::: "memory"); __builtin_amdgcn_s_barrier(); asm volatile("" ::: "memory");
#pragma unroll
        for (int bj = 0; bj < 2; ++bj) {
            const int c0 = u.pn * 256 + bj * 128 + wc * 32 + 8 * fq;
            const f32x4 g0 = *(const f32x4*)(gfin + c0), g1 = *(const f32x4*)(gfin + c0 + 4);
#pragma unroll
            for (int ai = 0; ai < 2; ++ai)
#pragma unroll
                for (int m = 0; m < 4; ++m) {
                    const int rl = rl0 + ai * 128 + m * 16; const float rr = S[rl]; float* o = OUT + (size_t)(u.pm * 256 + rl) * DM + c0;
                    *(f32x4*)o = acc[ai][bj][m][0] * rr * g0; *(f32x4*)(o + 4) = acc[ai][bj][m][1] * rr * g1;
                }
        }
    }
};
struct EpiGU {
    const float* SS; bf16_t* ACT;
    DI void operator()(const Acc& acc, const Unit& u, int wr, int wc, int fr, int fq) const {
        const int row0 = u.pm * 256 + wr * 64 + fr;
#pragma unroll
        for (int ai = 0; ai < 2; ++ai)
#pragma unroll
            for (int m = 0; m < 4; ++m) {
                const int r = row0 + ai * 128 + m * 16;
                const f32x4* sp = (const f32x4*)(SS + (size_t)r * 16);
                const f32x4 s0 = sp[0], s1 = sp[1], s2 = sp[2], s3 = sp[3];
                const float tot = ((s0[0] + s0[1]) + (s0[2] + s0[3])) + ((s1[0] + s1[1]) + (s1[2] + s1[3])) + ((s2[0] + s2[1]) + (s2[2] + s2[3])) + ((s3[0] + s3[1]) + (s3[2] + s3[3]));
                const float rr = 1.0f / sqrtf(tot * (1.0f / DM) + EPS);
#pragma unroll
                for (int bj = 0; bj < 2; ++bj) {
                    const int f0 = u.pn * 128 + bj * 64 + wc * 16 + 4 * fq;
                    const f32x4 g = acc[ai][bj][m][0] * rr, up = acc[ai][bj][m][1] * rr;
                    float o[4];
#pragma unroll
                    for (int i = 0; i < 4; ++i) o[i] = g[i] * sigmoidf_(g[i]) * up[i];
                    u32x2 w; w.x = pk2(o[0], o[1]); w.y = pk2(o[2], o[3]);
                    *(u32x2*)(ACT + (size_t)r * DFF + f0) = w;
                }
            }
    }
};


#ifndef EN_DSA
#define EN_DSA 1
#endif
#ifndef EN_WIN
#define EN_WIN 1
#endif
#ifndef EN_SLC
#define EN_SLC 1
#endif
#ifndef EN_CMP
#define EN_CMP 1
#endif
#define MFMA32(a, b, c) __builtin_amdgcn_mfma_f32_32x32x16_bf16((a), (b), (c), 0, 0, 0)
typedef short v4i16_t __attribute__((ext_vector_type(4)));
constexpr float SM_C = 0.125f * 1.4426950408889634f;
constexpr float NINF = -__builtin_inff();
DI int crow(int r, int h) { return (r & 3) + 8 * (r >> 2) + 4 * h; }
DI float fexp2(float x) { return __builtin_amdgcn_exp2f(x); }
DI s16x4 vtr(const LAS unsigned char* p) { return __builtin_bit_cast(s16x4, __builtin_amdgcn_ds_read_tr16_b64_v4i16((LAS v4i16_t*)p)); }
DI bf16x8 pack8(const f32x16& p, int s) {
    u32x4 w; w.x = pk2(p[8 * s], p[8 * s + 1]); w.y = pk2(p[8 * s + 2], p[8 * s + 3]); w.z = pk2(p[8 * s + 4], p[8 * s + 5]); w.w = pk2(p[8 * s + 6], p[8 * s + 7]);
    return __builtin_bit_cast(bf16x8, w);
}
DI f32x16 f16zero() { f32x16 z;
#pragma unroll
    for (int i = 0; i < 16; ++i) z[i] = 0.f;
    return z; }
struct FState { f32x16 o0, o1; float m, l; };
DI void fs_reset(FState& st) { st.o0 = f16zero(); st.o1 = f16zero(); st.m = NINF; st.l = 0.f; }
DI void flash_qk_bias(const LAS unsigned char* kb, const bf16x8 (&qf)[4], f32x16& p0, f32x16& p1, int r32, int h, const bf16x8& m0, const bf16x8& m1, const bf16x8& ef) {
    p0 = MFMA32(m0, ef, f16zero()); p1 = MFMA32(m1, ef, f16zero());
    const int sw = (r32 >> 1) & 7;
#pragma unroll
    for (int s = 0; s < 4; ++s) {
        const int off = r32 * 128 + (((2 * s + h) ^ sw) << 4);
        const bf16x8 a0 = *(const LAS bf16x8*)(kb + off), a1 = *(const LAS bf16x8*)(kb + off + 4096);
        p0 = MFMA32(a0, qf[s], p0); p1 = MFMA32(a1, qf[s], p1);
    }
}
DI void flash_qk(const LAS unsigned char* kb, const bf16x8 (&qf)[4], f32x16& p0, f32x16& p1, int r32, int h) {
    p0 = f16zero(); p1 = f16zero();
    const int sw = (r32 >> 1) & 7;
#pragma unroll
    for (int s = 0; s < 4; ++s) {
        const int off = r32 * 128 + (((2 * s + h) ^ sw) << 4);
        const bf16x8 a0 = *(const LAS bf16x8*)(kb + off), a1 = *(const LAS bf16x8*)(kb + off + 4096);
        p0 = MFMA32(a0, qf[s], p0); p1 = MFMA32(a1, qf[s], p1);
    }
}
DI unsigned cvtpk(float lo, float hi) { const f32x2 v = {lo, hi}; const bf16x2_t b = __builtin_convertvector(v, bf16x2_t); return __builtin_bit_cast(unsigned, b); }
DI bf16x8 pack8h(const f32x16& p, int s) {
    u32x4 w; w.x = cvtpk(p[8 * s], p[8 * s + 1]); w.y = cvtpk(p[8 * s + 2], p[8 * s + 3]); w.z = cvtpk(p[8 * s + 4], p[8 * s + 5]); w.w = cvtpk(p[8 * s + 6], p[8 * s + 7]);
    return __builtin_bit_cast(bf16x8, w);
}
DI float half_max(float v) { return fmaxf(v, __shfl_xor(v, 32)); }
DI float half_sum(float v) { return v + __shfl_xor(v, 32); }
constexpr float THR_RAW = 8.0f / SM_C;
DI void flash_pv(FState& st, f32x16& p0, f32x16& p1, bool rowon, const LAS unsigned char* vb, int lane) {
    float mx = fmaxf(p0[0], p1[0]);
#pragma unroll
    for (int r = 1; r < 16; ++r) asm("v_max3_f32 %0, %1, %2, %3" : "=v"(mx) : "v"(mx), "v"(p0[r]), "v"(p1[r]));
    mx = half_max(mx);
    mx = rowon ? mx : NINF;
    const bool upd = mx > st.m + THR_RAW;
    if (__any(upd)) {
        const float mn = upd ? mx : st.m;
        const float alpha = upd ? fexp2((st.m - mn) * SM_C) : 1.0f;
        st.m = mn; st.l *= alpha;
#pragma unroll
        for (int r = 0; r < 16; ++r) { st.o0[r] *= alpha; st.o1[r] *= alpha; }
    }
    const float cl = rowon ? SM_C : 0.0f;
    const float bl = rowon ? ((st.m == NINF) ? 0.0f : -st.m * SM_C) : NINF;
    float sum = 0.f;
#pragma unroll
    for (int r = 0; r < 16; ++r) { p0[r] = fexp2(__builtin_fmaf(p0[r], cl, bl)); p1[r] = fexp2(__builtin_fmaf(p1[r], cl, bl)); sum += p0[r] + p1[r]; }
    st.l += sum;
    const int h = lane >> 5;
    const int vx = (((lane & 15) >> 3) & 1) * 64;
    const LAS unsigned char* vp = vb + (4 * h + ((lane & 15) >> 2)) * 128 + ((lane >> 4) & 1) * 32 + (lane & 3) * 8;
#pragma unroll
    for (int sub = 0; sub < 2; ++sub)
#pragma unroll
        for (int s2 = 0; s2 < 2; ++s2) {
            const bf16x8 pf = pack8h(sub ? p1 : p0, s2);
            const LAS unsigned char* vq = vp + (32 * sub + 16 * s2) * 128;
            { const s16x4 lo = vtr(vq + vx), hi = vtr(vq + 1024 + vx); const bf16x8 vf = {lo[0], lo[1], lo[2], lo[3], hi[0], hi[1], hi[2], hi[3]}; st.o0 = MFMA32(vf, pf, st.o0); }
            { const s16x4 lo = vtr(vq + (64 - vx)), hi = vtr(vq + 1024 + (64 - vx)); const bf16x8 vf = {lo[0], lo[1], lo[2], lo[3], hi[0], hi[1], hi[2], hi[3]}; st.o1 = MFMA32(vf, pf, st.o1); }
        }
}
DI void flash_pv2(FState& sa, FState& sb, f32x16& a0, f32x16& a1, bool rona, f32x16& b0, f32x16& b1, bool ronb, const LAS unsigned char* va, const LAS unsigned char* vbb, int lane) {
    float mxa = fmaxf(a0[0], a1[0]), mxb = fmaxf(b0[0], b1[0]);
#pragma unroll
    for (int r = 1; r < 16; ++r) { asm("v_max3_f32 %0, %1, %2, %3" : "=v"(mxa) : "v"(mxa), "v"(a0[r]), "v"(a1[r])); asm("v_max3_f32 %0, %1, %2, %3" : "=v"(mxb) : "v"(mxb), "v"(b0[r]), "v"(b1[r])); }
    mxa = half_max(mxa); mxb = half_max(mxb);
    mxa = rona ? mxa : NINF; mxb = ronb ? mxb : NINF;
    const bool upa = mxa > sa.m + THR_RAW, upb = mxb > sb.m + THR_RAW;
    if (__any(upa || upb)) {
        const float mna = upa ? mxa : sa.m, mnb = upb ? mxb : sb.m;
        const float ala = upa ? fexp2((sa.m - mna) * SM_C) : 1.0f, alb = upb ? fexp2((sb.m - mnb) * SM_C) : 1.0f;
        sa.m = mna; sa.l *= ala; sb.m = mnb; sb.l *= alb;
#pragma unroll
        for (int r = 0; r < 16; ++r) { sa.o0[r] *= ala; sa.o1[r] *= ala; sb.o0[r] *= alb; sb.o1[r] *= alb; }
    }
    const float cla = rona ? SM_C : 0.0f, bla = rona ? ((sa.m == NINF) ? 0.0f : -sa.m * SM_C) : NINF;
    const float clb = ronb ? SM_C : 0.0f, blb = ronb ? ((sb.m == NINF) ? 0.0f : -sb.m * SM_C) : NINF;
    float suma = 0.f, sumb = 0.f;
#pragma unroll
    for (int r = 0; r < 16; ++r) {
        a0[r] = fexp2(__builtin_fmaf(a0[r], cla, bla)); b0[r] = fexp2(__builtin_fmaf(b0[r], clb, blb));
        a1[r] = fexp2(__builtin_fmaf(a1[r], cla, bla)); b1[r] = fexp2(__builtin_fmaf(b1[r], clb, blb));
        suma += a0[r] + a1[r]; sumb += b0[r] + b1[r];
    }
    sa.l += suma; sb.l += sumb;
    const int h = lane >> 5;
    const int vx = (((lane & 15) >> 3) & 1) * 64;
    const int voff = (4 * h + ((lane & 15) >> 2)) * 128 + ((lane >> 4) & 1) * 32 + (lane & 3) * 8;
#pragma unroll
    for (int sub = 0; sub < 2; ++sub)
#pragma unroll
        for (int s2 = 0; s2 < 2; ++s2) {
            const bf16x8 pfa = pack8h(sub ? a1 : a0, s2), pfb = pack8h(sub ? b1 : b0, s2);
            const LAS unsigned char* qa = va + voff + (32 * sub + 16 * s2) * 128; const LAS unsigned char* qb = vbb + voff + (32 * sub + 16 * s2) * 128;
            { const s16x4 lo = vtr(qa + vx), hi = vtr(qa + 1024 + vx); const bf16x8 vf = {lo[0], lo[1], lo[2], lo[3], hi[0], hi[1], hi[2], hi[3]}; sa.o0 = MFMA32(vf, pfa, sa.o0); }
            { const s16x4 lo = vtr(qb + vx), hi = vtr(qb + 1024 + vx); const bf16x8 vf = {lo[0], lo[1], lo[2], lo[3], hi[0], hi[1], hi[2], hi[3]}; sb.o0 = MFMA32(vf, pfb, sb.o0); }
            { const s16x4 lo = vtr(qa + (64 - vx)), hi = vtr(qa + 1024 + (64 - vx)); const bf16x8 vf = {lo[0], lo[1], lo[2], lo[3], hi[0], hi[1], hi[2], hi[3]}; sa.o1 = MFMA32(vf, pfa, sa.o1); }
            { const s16x4 lo = vtr(qb + (64 - vx)), hi = vtr(qb + 1024 + (64 - vx)); const bf16x8 vf = {lo[0], lo[1], lo[2], lo[3], hi[0], hi[1], hi[2], hi[3]}; sb.o1 = MFMA32(vf, pfb, sb.o1); }
        }
}
DI void fs_merge(FState& sa, const FState& sb) {
    const float m = fmaxf(sa.m, sb.m), mu = (m == NINF) ? 0.0f : m;
    const float fa = fexp2((sa.m - mu) * SM_C), fb = fexp2((sb.m - mu) * SM_C);
    sa.m = m; sa.l = sa.l * fa + sb.l * fb;
#pragma unroll
    for (int r = 0; r < 16; ++r) { sa.o0[r] = sa.o0[r] * fa + sb.o0[r] * fb; sa.o1[r] = sa.o1[r] * fa + sb.o1[r] * fb; }
}
DI void store_y(bf16_t* dst, const f32x16& y0, const f32x16& y1, int h) {
#pragma unroll
    for (int mm = 0; mm < 4; ++mm) {
        u32x2 w0; w0.x = pk2(y0[4 * mm], y0[4 * mm + 1]); w0.y = pk2(y0[4 * mm + 2], y0[4 * mm + 3]);
        u32x2 w1; w1.x = pk2(y1[4 * mm], y1[4 * mm + 1]); w1.y = pk2(y1[4 * mm + 2], y1[4 * mm + 3]);
        *(u32x2*)(dst + 8 * mm + 4 * h) = w0; *(u32x2*)(dst + 32 + 8 * mm + 4 * h) = w1;
    }
}

DI void nsa_task(LAS unsigned char* lds, const bf16_t* Z, const unsigned* selm, const bf16_t* OCMP, bf16_t* YA, int b, int hk, int c, int tid, int wave, int lane) {
    const int r32 = lane & 31, h = lane >> 5;
    const int tok = 64 * c + 8 * wave + (r32 >> 2), head = hk * 4 + (r32 & 3);
    const size_t grow = (size_t)b * SEQ + tok;
    const bf16_t* zr = Z + grow * NZ;
    bf16x8 qf[4];
#pragma unroll
    for (int s = 0; s < 4; ++s) qf[s] = *(const bf16x8*)(zr + ZC_QA + head * 64 + 16 * s + 8 * h);
    const unsigned selw = EN_SLC ? selm[grow * 2 + hk] : 0u;
    const float g_cmp = sigmoidf_(bf2f(zr[ZC_GA + head])), g_slc = sigmoidf_(bf2f(zr[ZC_GA + 8 + head])), g_win = sigmoidf_(bf2f(zr[ZC_GA + 16 + head]));
    f32x16 y0 = f16zero(), y1 = f16zero();
    FState st; fs_reset(st);
    const int nsel = EN_SLC ? c + 1 : 0, nwin = EN_WIN ? (c + 1 < 9 ? c + 1 : 9) : 0, ntot = nsel + nwin;
    const int skey = tid >> 3, sch = tid & 7;
    const int kdst = skey * 128 + ((sch ^ ((skey >> 1) & 7)) << 4), vdst = 8192 + skey * 128 + ((sch * 16) ^ (((skey >> 1) & 1) << 6));
    const bf16_t* sbase = Z + ((size_t)b * SEQ + skey) * NZ + hk * 64 + sch * 8;
    u32x4 kA = {0u, 0u, 0u, 0u}, vA = kA, kB = kA, vB = kA, kC = kA, vC = kA;
#define NSA_LOADT(it_, KR, VR) do { const int i_ = (it_); if (i_ < ntot) { const bool s_ = i_ < nsel; const int j_ = s_ ? i_ : c - (i_ - nsel); const bf16_t* p_ = sbase + (size_t)(64 * j_) * NZ; \
        KR = *(const u32x4*)(p_ + (s_ ? ZC_KS : ZC_KW)); VR = *(const u32x4*)(p_ + (s_ ? ZC_VS : ZC_VW)); } } while (0)
#define NSA_FINAL(gate_) do { const float lt_ = half_sum(st.l); const float inv_ = lt_ > 0.f ? (gate_) / lt_ : 0.f; \
        _Pragma("unroll") for (int r = 0; r < 16; ++r) { y0[r] += st.o0[r] * inv_; y1[r] += st.o1[r] * inv_; } fs_reset(st); } while (0)
#define NSA_STEP(it_, KR, VR) do { const int it = (it_); \
        LAS unsigned char* buf = lds + (it & 1) * 16384; \
        *(LAS u32x4*)(buf + kdst) = KR; *(LAS u32x4*)(buf + vdst) = VR; \
        __syncthreads(); \
        NSA_LOADT(it + 3, KR, VR); \
        if (it == nsel && nsel > 0) NSA_FINAL(g_slc); \
        const bool is_sel = it < nsel; const int j = is_sel ? it : c - (it - nsel); \
        f32x16 p0, p1; flash_qk(buf, qf, p0, p1, r32, h); \
        const int kb0 = 64 * j + 4 * h; \
        bool rowon = true; \
        if (is_sel) { \
            rowon = (selw >> j) & 1u; \
            if (j == c) { \
                _Pragma("unroll") for (int r = 0; r < 16; ++r) { const int kp = kb0 + (r & 3) + 8 * (r >> 2); p0[r] = (kp <= tok) ? p0[r] : NINF; p1[r] = (kp + 32 <= tok) ? p1[r] : NINF; } \
            } \
        } else if (j == c || j == c - 8) { \
            _Pragma("unroll") for (int r = 0; r < 16; ++r) { const int kp = kb0 + (r & 3) + 8 * (r >> 2); \
                p0[r] = (kp <= tok && kp > tok - 512) ? p0[r] : NINF; p1[r] = (kp + 32 <= tok && kp + 32 > tok - 512) ? p1[r] : NINF; } \
        } \
        flash_pv(st, p0, p1, rowon, buf + 8192, lane); } while (0)
    NSA_LOADT(0, kA, vA); NSA_LOADT(1, kB, vB); NSA_LOADT(2, kC, vC);
    for (int it0 = 0; it0 < ntot; it0 += 3) {
        NSA_STEP(it0, kA, vA);
        if (it0 + 1 < ntot) NSA_STEP(it0 + 1, kB, vB);
        if (it0 + 2 < ntot) NSA_STEP(it0 + 2, kC, vC);
    }
    if (nwin > 0) NSA_FINAL(g_win); else if (nsel > 0) NSA_FINAL(g_slc);
    if (EN_CMP) {
        const bf16_t* oc = OCMP + grow * 512 + head * 64;
#pragma unroll
        for (int mm = 0; mm < 4; ++mm) {
            const u32x2 w0 = *(const u32x2*)(oc + 8 * mm + 4 * h), w1 = *(const u32x2*)(oc + 32 + 8 * mm + 4 * h);
            y0[4 * mm] += g_cmp * bflo(w0.x); y0[4 * mm + 1] += g_cmp * bfhi(w0.x); y0[4 * mm + 2] += g_cmp * bflo(w0.y); y0[4 * mm + 3] += g_cmp * bfhi(w0.y);
            y1[4 * mm] += g_cmp * bflo(w1.x); y1[4 * mm + 1] += g_cmp * bfhi(w1.x); y1[4 * mm + 2] += g_cmp * bflo(w1.y); y1[4 * mm + 3] += g_cmp * bfhi(w1.y);
        }
    }
    store_y(YA + grow * 1024 + head * 64, y0, y1, h);
    __syncthreads();
#undef NSA_LOADT
#undef NSA_FINAL
#undef NSA_STEP
}

DI void dsa_task(LAS unsigned char* lds, const bf16_t* Z, const unsigned* dmask, bf16_t* YB, int b, int qi, int tid, int wave, int lane) {
    const int r32 = lane & 31, h = lane >> 5;
    const int tok = 32 * qi + 4 * wave + (r32 >> 3), head = r32 & 7;
    const size_t grow = (size_t)b * SEQ + tok;
    const bf16_t* zr = Z + grow * NZ;
    bf16x8 qf[4];
#pragma unroll
    for (int s = 0; s < 4; ++s) qf[s] = *(const bf16x8*)(zr + ZC_QB + head * 64 + 16 * s + 8 * h);
    const unsigned* dmw = dmask + ((size_t)b * SEQ + 32 * qi + 4 * wave) * 64;
    FState st, sb; fs_reset(st); fs_reset(sb);
    const int ntot = (qi >> 1) + 1, npair = (ntot + 1) >> 1;
    const int skey = tid >> 3, sch = tid & 7;
    const bf16_t* srow = Z + ((size_t)b * SEQ + skey) * NZ;
    const int kch = (sch ^ ((skey >> 1) & 7)) * 8, vch = (sch ^ (((skey >> 1) & 1) << 2)) * 8;
    const int wbase = wave * 1024;
#define DSA_DMA(p_) do { const int pp_ = (p_); if (pp_ < npair) { const int t0_ = 2 * pp_, t1_ = (2 * pp_ + 1 < ntot) ? 2 * pp_ + 1 : ntot - 1; LAS unsigned char* st_ = lds + (pp_ & 1) * 32768 + wbase; \
        const bf16_t* q0_ = srow + (size_t)(64 * t0_) * NZ; const bf16_t* q1_ = srow + (size_t)(64 * t1_) * NZ; \
        __builtin_amdgcn_global_load_lds((const unsigned*)(q0_ + ZC_KB + kch), (LAS unsigned*)(st_), 16, 0, 0); \
        __builtin_amdgcn_global_load_lds((const unsigned*)(q0_ + ZC_VB + vch), (LAS unsigned*)(st_ + 8192), 16, 0, 0); \
        __builtin_amdgcn_global_load_lds((const unsigned*)(q1_ + ZC_KB + kch), (LAS unsigned*)(st_ + 16384), 16, 0, 0); \
        __builtin_amdgcn_global_load_lds((const unsigned*)(q1_ + ZC_VB + vch), (LAS unsigned*)(st_ + 24576), 16, 0, 0); } } while (0)
#define DSA_MFRAG(dst, W0, W1, W2, W3) do { u32x4 m_ = {0u, 0u, 0u, 0u}; \
        if (h == 0) { m_.x = (__builtin_amdgcn_ubfe(~(W0), (unsigned)r32, 1u) | (__builtin_amdgcn_ubfe(~(W1), (unsigned)r32, 1u) << 16)) * 0xC700u; \
                      m_.y = (__builtin_amdgcn_ubfe(~(W2), (unsigned)r32, 1u) | (__builtin_amdgcn_ubfe(~(W3), (unsigned)r32, 1u) << 16)) * 0xC700u; } \
        dst = __builtin_bit_cast(bf16x8, m_); } while (0)
#define DSA_PAIR(p_) do { const int p = (p_); \
        LAS unsigned char* bufA = lds + (p & 1) * 32768; LAS unsigned char* bufB = bufA + 16384; \
        asm volatile("s_waitcnt vmcnt(0)" ::: "memory"); \
        __syncthreads(); \
        DSA_DMA(p + 1); \
        const u32x4 c0_ = wq0, c1_ = wq1, c2_ = wq2, c3_ = wq3; \
        if (p + 1 < npair) { wq0 = *(const u32x4*)(dmw + 4 * (p + 1)); wq1 = *(const u32x4*)(dmw + 64 + 4 * (p + 1)); wq2 = *(const u32x4*)(dmw + 128 + 4 * (p + 1)); wq3 = *(const u32x4*)(dmw + 192 + 4 * (p + 1)); } \
        bf16x8 efrag; { int lane_ = lane; asm volatile("" : "+v"(lane_)); const int tk = (lane_ & 31) >> 3; u32x4 e = {0u, 0u, 0u, 0u};   \
          if ((lane_ >> 5) == 0) { e.x = (tk == 0 ? 0x3F80u : 0u) | (tk == 1 ? 0x3F800000u : 0u); e.y = (tk == 2 ? 0x3F80u : 0u) | (tk == 3 ? 0x3F800000u : 0u); } \
          efrag = __builtin_bit_cast(bf16x8, e); } \
        bf16x8 ma0, ma1, mb0, mb1; DSA_MFRAG(ma0, c0_.x, c1_.x, c2_.x, c3_.x); DSA_MFRAG(ma1, c0_.y, c1_.y, c2_.y, c3_.y); DSA_MFRAG(mb0, c0_.z, c1_.z, c2_.z, c3_.z); DSA_MFRAG(mb1, c0_.w, c1_.w, c2_.w, c3_.w); \
        f32x16 pa0, pa1, pb0, pb1; flash_qk_bias(bufA, qf, pa0, pa1, r32, h, ma0, ma1, efrag); flash_qk_bias(bufB, qf, pb0, pb1, r32, h, mb0, mb1, efrag); \
        flash_pv2(st, sb, pa0, pa1, true, pb0, pb1, 2 * p + 1 < ntot, bufA + 8192, bufB + 8192, lane); } while (0)
    u32x4 wq0 = *(const u32x4*)(dmw), wq1 = *(const u32x4*)(dmw + 64), wq2 = *(const u32x4*)(dmw + 128), wq3 = *(const u32x4*)(dmw + 192);
    DSA_DMA(0);
    for (int p0_ = 0; p0_ < npair; ++p0_) DSA_PAIR(p0_);
#undef DSA_DMA
#undef DSA_MFRAG
#undef DSA_PAIR
    fs_merge(st, sb);
    const float lt = half_sum(st.l); const float inv = lt > 0.f ? 1.0f / lt : 0.f;
#pragma unroll
    for (int r = 0; r < 16; ++r) { st.o0[r] *= inv; st.o1[r] *= inv; }
    store_y(YB + grow * 1024 + 512 + head * 64, st.o0, st.o1, h);
    __syncthreads();
}


DI float gelu_tanh(float x) { const float u = 0.7978845608028654f * (x + 0.044715f * x * x * x); const float t = 1.0f - 2.0f / (__expf(2.0f * u) + 1.0f); return 0.5f * x * (1.0f + t); }
DI void compress_task(LAS unsigned char* lds, const bf16_t* Z, const bf16_t* W1t, const bf16_t* W2t, const float* bias1, bf16_t* KCC, bf16_t* VCT, int kv, int b, int hk, int nt4, int tid, int wave, int lane) {
    const int r32 = lane & 31, h = lane >> 5;
    const int n0 = 32 * nt4;
    const int srow = tid >> 3, sch = tid & 7;
    const bf16_t* asrc = W1t + (size_t)srow * 2048 + sch * 8;
    const int adst = srow * 128 + ((sch ^ ((srow >> 1) & 7)) << 4);
    const int nb = (n0 + srow > 126) ? 126 : n0 + srow;
    const bf16_t* bsrc = Z + ((size_t)b * SEQ + nb * 16) * NZ + (kv ? ZC_VC : ZC_KC) + hk * 64 + sch * 8;
    const bool bthr = tid < 256;
    const int aoff = (32 * wave + r32) * 128, boff = 32768 + r32 * 128, sw = (r32 >> 1) & 7;
    u32x4 a0[4], a1[4], b0v = {0u, 0u, 0u, 0u}, b1v = b0v;
#define CMP_LOAD(tk_, AR, BR) do { const int t_ = (tk_); if (t_ < 32) { _Pragma("unroll") for (int i = 0; i < 4; ++i) AR[i] = *(const u32x4*)(asrc + (size_t)i * 64 * 2048 + t_ * 64); \
        if (bthr) BR = *(const u32x4*)(bsrc + (size_t)t_ * NZ); } } while (0)
#define CMP_STEP(tk_, AR, BR, ST) do { LAS unsigned char* st_ = lds + (ST) * 36864; \
        _Pragma("unroll") for (int i = 0; i < 4; ++i) *(LAS u32x4*)(st_ + adst + i * 8192) = AR[i]; \
        if (bthr) *(LAS u32x4*)(st_ + 32768 + adst) = BR; \
        __syncthreads(); \
        CMP_LOAD((tk_) + 2, AR, BR); \
        _Pragma("unroll") for (int s = 0; s < 4; ++s) { const int co = ((2 * s + h) ^ sw) << 4; \
            const bf16x8 af = *(const LAS bf16x8*)(st_ + aoff + co); const bf16x8 bq = *(const LAS bf16x8*)(st_ + boff + co); acc = MFMA32(af, bq, acc); } } while (0)
    f32x16 acc = f16zero();
    CMP_LOAD(0, a0, b0v); CMP_LOAD(1, a1, b1v);
    for (int tk = 0; tk < 32; tk += 2) { CMP_STEP(tk, a0, b0v, 0); CMP_STEP(tk + 1, a1, b1v, 1); }
#undef CMP_LOAD
#undef CMP_STEP
    __syncthreads();
#pragma unroll
    for (int r = 0; r < 16; ++r) acc[r] = gelu_tanh(acc[r] + bias1[kv * 256 + 32 * wave + crow(r, h)]);
    f32x16 part0 = f16zero(), part1 = f16zero();
#pragma unroll
    for (int s2 = 0; s2 < 2; ++s2) {
        const bf16x8 pf = pack8(acc, s2);
#pragma unroll
        for (int dt = 0; dt < 2; ++dt) {
            const bf16_t* wp = W2t + (size_t)(32 * dt + r32) * 256 + 32 * wave + 16 * s2 + 4 * h;
            const u32x2 lo = *(const u32x2*)wp, hi = *(const u32x2*)(wp + 8);
            const u32x4 w4 = {lo.x, lo.y, hi.x, hi.y}; const bf16x8 wf = __builtin_bit_cast(bf16x8, w4);
            if (dt == 0) part0 = MFMA32(wf, pf, part0); else part1 = MFMA32(wf, pf, part1);
        }
    }
    LAS float* red = (LAS float*)lds;
#pragma unroll
    for (int r = 0; r < 16; ++r) { red[wave * 2048 + crow(r, h) * 32 + r32] = part0[r]; red[wave * 2048 + (32 + crow(r, h)) * 32 + r32] = part1[r]; }
    __syncthreads();
    const int nn = tid & 31, d4 = tid >> 5; float o[4];
#pragma unroll
    for (int e = 0; e < 4; ++e) { float s = 0.f;
#pragma unroll
        for (int w = 0; w < 8; ++w) s += red[w * 2048 + (4 * d4 + e) * 32 + nn];
        o[e] = s; }
    const int ng = n0 + nn;
    if (kv == 0) { u32x2 w; w.x = pk2(o[0], o[1]); w.y = pk2(o[2], o[3]); *(u32x2*)(KCC + ((size_t)(b * 2 + hk) * 128 + ng) * 64 + 4 * d4) = w; }
    else {
#pragma unroll
        for (int e = 0; e < 4; ++e) VCT[((size_t)(b * 2 + hk) * 64 + 4 * d4 + e) * 128 + ng] = (bf16_t)f2bf(o[e]);
    }
    __syncthreads();
}

DI void cmp_task(const bf16_t* Z, const bf16_t* KCC, const bf16_t* VCT, bf16_t* OCMP, unsigned* selm, int b, int hk, int tg, int lane) {
    const int r32 = lane & 31, h = lane >> 5;
    const int tok = 8 * tg + (r32 >> 2), g = r32 & 3, head = hk * 4 + g;
    const size_t grow = (size_t)b * SEQ + tok;
    const bf16_t* zr = Z + grow * NZ;
    bf16x8 qf[4];
#pragma unroll
    for (int s = 0; s < 4; ++s) qf[s] = *(const bf16x8*)(zr + ZC_QA + head * 64 + 16 * s + 8 * h);
    const bf16_t* kc = KCC + (size_t)(b * 2 + hk) * 128 * 64; const bf16_t* vt = VCT + (size_t)(b * 2 + hk) * 64 * 128;
    const int tmax = 8 * tg + 7;
    const int nsub = tmax < 31 ? 0 : (((tmax - 31) >> 4) >> 5) + 1;
    f32x16 p[4];
#pragma unroll
    for (int sub = 0; sub < 4; ++sub) {
        if (sub < nsub) {
            p[sub] = f16zero();
#pragma unroll
            for (int s = 0; s < 4; ++s) { const bf16x8 af = *(const bf16x8*)(kc + (size_t)(32 * sub + r32) * 64 + 16 * s + 8 * h); p[sub] = MFMA32(af, qf[s], p[sub]); }
#pragma unroll
            for (int r = 0; r < 16; ++r) { const int n = 32 * sub + crow(r, h); p[sub][r] = (16 * n + 31 <= tok) ? p[sub][r] * SM_C : NINF; }
        } else {
#pragma unroll
            for (int r = 0; r < 16; ++r) p[sub][r] = NINF;
        }
    }
    float mx = NINF;
#pragma unroll
    for (int sub = 0; sub < 4; ++sub)
#pragma unroll
        for (int r = 0; r < 16; ++r) mx = fmaxf(mx, p[sub][r]);
    mx = fmaxf(mx, __shfl_xor(mx, 32));
    const float mu = (mx == NINF) ? 0.f : mx;
    float sum = 0.f;
#pragma unroll
    for (int sub = 0; sub < 4; ++sub)
#pragma unroll
        for (int r = 0; r < 16; ++r) { p[sub][r] = fexp2(p[sub][r] - mu); sum += p[sub][r]; }
    const float lt = sum + __shfl_xor(sum, 32); const float inv = lt > 0.f ? 1.0f / lt : 0.f;
#pragma unroll
    for (int sub = 0; sub < 4; ++sub)
#pragma unroll
        for (int r = 0; r < 16; ++r) p[sub][r] *= inv;
    f32x16 o0 = f16zero(), o1 = f16zero();
#pragma unroll
    for (int sub = 0; sub < 4; ++sub) if (sub < nsub) {
#pragma unroll
        for (int s2 = 0; s2 < 2; ++s2) {
            const bf16x8 pf = pack8(p[sub], s2);
#pragma unroll
            for (int dt = 0; dt < 2; ++dt) {
                const bf16_t* wp = vt + (size_t)(32 * dt + r32) * 128 + 32 * sub + 16 * s2 + 4 * h;
                const u32x2 lo = *(const u32x2*)wp, hi = *(const u32x2*)(wp + 8);
                const u32x4 w4 = {lo.x, lo.y, hi.x, hi.y}; const bf16x8 vf = __builtin_bit_cast(bf16x8, w4);
                if (dt == 0) o0 = MFMA32(vf, pf, o0); else o1 = MFMA32(vf, pf, o1);
            }
        }
    }
    store_y(OCMP + grow * 512 + head * 64, o0, o1, h);
    const int cur = tg >> 3; unsigned mask;
    if (cur <= 7) mask = (2u << cur) - 1u;
    else {
        float a[4][4], PL[4][4];
#pragma unroll
        for (int T = 0; T < 4; ++T)
#pragma unroll
            for (int mm = 0; mm < 4; ++mm) { a[T][mm] = (p[T][4 * mm] + p[T][4 * mm + 1]) + (p[T][4 * mm + 2] + p[T][4 * mm + 3]); PL[T][mm] = __shfl_xor(p[T][4 * mm + 3], 32); }
#pragma unroll
        for (int T = 0; T < 4; ++T)
#pragma unroll
            for (int mm = 0; mm < 4; ++mm) { const float prev = mm > 0 ? PL[T][mm - 1] : (T > 0 ? PL[T - 1][3] : 0.f); a[T][mm] += h ? PL[T][mm] : prev; }
        float ev[4][4], od[4][4], mine[4];
#pragma unroll
        for (int T = 0; T < 4; ++T)
#pragma unroll
            for (int mm = 0; mm < 4; ++mm) {
                float v = a[T][mm]; v += __shfl_xor(v, 1); v += __shfl_xor(v, 2);
                const int j = 8 * T + 2 * mm + h; v = (j >= 1 && j <= cur - 2) ? v : -1.0f;
                const float vx = __shfl_xor(v, 32);
                ev[T][mm] = h ? vx : v; od[T][mm] = h ? v : vx; a[T][mm] = v;
            }
#pragma unroll
        for (int mm = 0; mm < 4; ++mm) mine[mm] = g == 0 ? a[0][mm] : g == 1 ? a[1][mm] : g == 2 ? a[2][mm] : a[3][mm];
        unsigned word = 0u;
#pragma unroll
        for (int mm = 0; mm < 4; ++mm) {
            const int jm = 8 * g + 2 * mm + h; const float v = mine[mm]; int rank = 0;
#pragma unroll
            for (int T = 0; T < 4; ++T)
#pragma unroll
                for (int m2 = 0; m2 < 4; ++m2) { const int je = 8 * T + 2 * m2;
                    rank += (ev[T][m2] > v || (ev[T][m2] == v && je < jm)) ? 1 : 0; rank += (od[T][m2] > v || (od[T][m2] == v && je + 1 < jm)) ? 1 : 0; }
            if (v >= 0.f && rank < 5) word |= 1u << jm;
        }
        word |= __shfl_xor(word, 1); word |= __shfl_xor(word, 2); word |= __shfl_xor(word, 32);
        mask = word | 1u | (1u << cur) | (1u << (cur - 1));
    }
    if (g == 0 && h == 0) selm[grow * 2 + hk] = mask;
}

constexpr size_t SC_PB = (size_t)64 * 64 * (32 * 33 / 2);
DI size_t sc_rowoff(int b, int t) { const int c = t >> 6; return (size_t)b * SC_PB + (size_t)4096 * (c * (c + 1) / 2) + (size_t)(t & 63) * (64 * (c + 1)); }
DI void score_range(const bf16_t* Z, float* SC, int i0, int i1, int lane) {
    const int r32 = lane & 31, h = lane >> 5;
    if (i0 >= i1) return;
    int b = i0 / 2080; const int rem = i0 - b * 2080;
    int qt = (int)((sqrtf(8.0f * (float)rem + 1.0f) - 1.0f) * 0.5f);
    while (qt * (qt + 1) / 2 > rem) --qt;
    while ((qt + 1) * (qt + 2) / 2 <= rem) ++qt;
    int sub = rem - qt * (qt + 1) / 2;
    bf16x8 qf[4][4]; float iwr[4][16]; float* sbase = nullptr; int Lrow = 0;
    bf16x8 kf[4], kn[4];
#define SCORE_LOADQ() do { const bf16_t* zq_ = Z + ((size_t)b * SEQ + 32 * qt) * NZ; \
        _Pragma("unroll") for (int hh = 0; hh < 4; ++hh) \
            _Pragma("unroll") for (int s = 0; s < 4; ++s) qf[hh][s] = *(const bf16x8*)(zq_ + (size_t)r32 * NZ + ZC_IQ + hh * 64 + 16 * s + 8 * h); \
        _Pragma("unroll") for (int r = 0; r < 16; ++r) { const u32x2 w_ = *(const u32x2*)(zq_ + (size_t)crow(r, h) * NZ + ZC_IW); \
            iwr[0][r] = bflo(w_.x) * 0.0625f; iwr[1][r] = bfhi(w_.x) * 0.0625f; iwr[2][r] = bflo(w_.y) * 0.0625f; iwr[3][r] = bfhi(w_.y) * 0.0625f; } \
        { const int c_ = qt >> 1; Lrow = 64 * (c_ + 1); sbase = SC + (size_t)b * SC_PB + (size_t)4096 * (c_ * (c_ + 1) / 2) + (size_t)((qt & 1) * 32 + 4 * h) * Lrow + r32; } } while (0)
#define SCORE_LOADK(dst, b_, sub_) do { const bf16_t* kr_ = Z + ((size_t)(b_) * SEQ + 32 * (sub_) + r32) * NZ + ZC_IK + 8 * h; \
        _Pragma("unroll") for (int s = 0; s < 4; ++s) dst[s] = *(const bf16x8*)(kr_ + 16 * s); } while (0)
    SCORE_LOADQ();
    SCORE_LOADK(kf, b, sub);
    for (int i = i0; i < i1; ++i) {
        int nb = b, nq = qt, ns = sub + 1;
        if (ns > nq) { ns = 0; ++nq; if (nq == 64) { nq = 0; ++nb; } }
        const bool more = i + 1 < i1;
        if (more) SCORE_LOADK(kn, nb, ns);
        f32x16 sc = f16zero();
#pragma unroll
        for (int hh = 0; hh < 4; ++hh) {
            f32x16 acc = f16zero();
#pragma unroll
            for (int s = 0; s < 4; ++s) acc = MFMA32(qf[hh][s], kf[s], acc);
#pragma unroll
            for (int r = 0; r < 16; ++r) sc[r] += iwr[hh][r] * fmaxf(acc[r], 0.f);
        }
#pragma unroll
        for (int r = 0; r < 16; ++r) sbase[(size_t)((r & 3) + 8 * (r >> 2)) * Lrow + 32 * sub] = sc[r];
        if (more) {
            const bool newq = (nq != qt) || (nb != b);
            b = nb; qt = nq; sub = ns;
            if (newq) SCORE_LOADQ();
#pragma unroll
            for (int s = 0; s < 4; ++s) kf[s] = kn[s];
        }
    }
#undef SCORE_LOADQ
#undef SCORE_LOADK
}

DI void select_row(const float* SC, unsigned* dmask, int b, int t, int lane) {
    unsigned* dm = dmask + ((size_t)b * SEQ + t) * 64;
    const int nvalid = t + 1;
    if (nvalid <= 256) {
        const int w = lane;
        const int lo = 32 * w; unsigned bits = 0u;
        if (lo + 31 <= t) bits = 0xffffffffu; else if (lo <= t) bits = (2u << (t - lo)) - 1u;
        dm[w] = bits; return;
    }
    const int nch = (nvalid + 255) >> 8;
    const float* srow = SC + sc_rowoff(b, t) + 4 * lane;
    unsigned u[8][4];
#pragma unroll
    for (int k = 0; k < 8; ++k) {
        if (k < nch) {
            const f32x4 v = *(const f32x4*)(srow + 256 * k);
#pragma unroll
            for (int e = 0; e < 4; ++e) { const unsigned bits = __builtin_bit_cast(unsigned, v[e] + 0.0f); const unsigned key = ((int)bits < 0) ? ~bits : (bits | 0x80000000u);
                u[k][e] = (256 * k + 4 * lane + e <= t) ? key : 0u; }
        } else { u[k][0] = 0u; u[k][1] = 0u; u[k][2] = 0u; u[k][3] = 0u; }
    }
#define SEL_COUNT(cand_, cnt_) do { unsigned cl_ = 0u; const unsigned cs_ = (cand_); \
        _Pragma("unroll") for (int k2 = 0; k2 < 4; ++k2) if (2 * k2 < nch) { \
            _Pragma("unroll") for (int q = 0; q < 8; ++q) asm("v_cmp_le_u32_e32 vcc, %2, %1\n\tv_addc_co_u32_e32 %0, vcc, 0, %0, vcc" : "+v"(cl_) : "v"(u[2 * k2 + (q >> 2)][q & 3]), "s"(cs_) : "vcc"); } \
        unsigned long long bb_[6]; \
        _Pragma("unroll") for (int q = 0; q < 6; ++q) bb_[q] = __ballot((cl_ >> q) & 1u); \
        cnt_ = 0; \
        _Pragma("unroll") for (int q = 0; q < 6; ++q) cnt_ += __popcll(bb_[q]) << q; } while (0)
    unsigned T = 0u; bool hit = false; int startbit = 31;
    {
        int cnt; SEL_COUNT(0xC0000000u, cnt);
        if (cnt < 256) {
#pragma unroll 1
            for (unsigned e = 0x7Fu; e >= 0x7Bu; --e) {
                const unsigned cand = 0x80000000u | (e << 23); SEL_COUNT(cand, cnt);
                if (cnt >= 256) { T = cand; startbit = 22; hit = (cnt == 256); break; }
            }
        }
    }
    if (!hit) {
        for (int bit = startbit; bit >= 0; --bit) {
            const unsigned cand = T | (1u << bit); int cnt; SEL_COUNT(cand, cnt);
            if (cnt >= 256) { T = cand; if (cnt == 256) { hit = true; break; } }
        }
    }
#undef SEL_COUNT
    int cgt = 0, cge = 256;
    if (!hit) { cge = 0;
#pragma unroll
    for (int k = 0; k < 8; ++k) if (k < nch) {
#pragma unroll
        for (int e = 0; e < 4; ++e) { cgt += __popcll(__ballot(u[k][e] > T)); cge += __popcll(__ballot(u[k][e] >= T)); }
    }
    }
    const int need = 256 - cgt;
    const bool exact = (cge == 256);
    int tie_before = 0;
    const unsigned long long ltmask = (1ull << lane) - 1ull;
#pragma unroll
    for (int k = 0; k < 8; ++k) {
        unsigned nib = 0u;
        if (k < nch) {
            if (exact) {
#pragma unroll
                for (int e = 0; e < 4; ++e) nib |= (u[k][e] >= T ? 1u : 0u) << e;
            } else {
                unsigned long long bm[4]; int lanes_before = 0, tot = 0;
#pragma unroll
                for (int e = 0; e < 4; ++e) { bm[e] = __ballot(u[k][e] == T); lanes_before += __popcll(bm[e] & ltmask); tot += __popcll(bm[e]); }
                int rank = tie_before + lanes_before;
#pragma unroll
                for (int e = 0; e < 4; ++e) { const bool eq = (u[k][e] == T); const bool s = (u[k][e] > T) || (eq && rank < need); nib |= (s ? 1u : 0u) << e; rank += eq ? 1 : 0; }
                tie_before += tot;
            }
        }
        unsigned val = nib << (4 * (lane & 7));
        val |= __shfl_xor(val, 1); val |= __shfl_xor(val, 2); val |= __shfl_xor(val, 4);
        if ((lane & 7) == 0) dm[8 * k + (lane >> 3)] = val;
    }
}

struct MapIdent { DI int operator()(int d, int& sel) const { sel = 0; return d; } };
struct MapInProj {
    DI int operator()(int c, int& sel) const {
        sel = 0;
        if (c < 1792) {
            const int hb = c >> 6, g = c & 63, w = g >> 5, fq = (g >> 3) & 3, n = (g >> 2) & 1, i = g & 3, d = 32 * n + 16 * w + 4 * fq + i;
            int base;
            if (hb < 8) base = 0 + 64 * hb; else if (hb < 10) base = 512 + 64 * (hb - 8); else if (hb < 12) base = 768 + 64 * (hb - 10); else if (hb < 14) base = 1024 + 64 * (hb - 12);
            else if (hb < 22) base = 1304 + 64 * (hb - 14); else if (hb < 23) base = 1816; else if (hb < 27) base = 1944 + 64 * (hb - 23); else base = 2200;
            return base + d;
        }
        if (c < 1920) return 640 + (c - 1792);
        if (c < 2048) return 896 + (c - 1920);
        if (c < 2176) return 1152 + (c - 2048);
        if (c < 2240) return 1880 + (c - 2176);
        if (c < 2264) return 1280 + (c - 2240);
        if (c < 2268) return 2264 + (c - 2264);
        if (c < 2304) return -1;
        return 2268 + (c - 2304);
    }
};
struct MapGU {
    DI int operator()(int c, int& sel) const {
        sel = (c >> 2) & 1;
        return 128 * (c >> 8) + 64 * ((c >> 7) & 1) + 16 * ((c >> 5) & 3) + 4 * ((c >> 3) & 3) + (c & 3);
    }
};
template <class Map>
DI void transpose_item(const float* W0, const float* W1, int N, int K, int Nd, const float* kscale, bf16_t* WT, Map map, LAS float* scr, int it, int lane, int ldk = 0, int koff = 0) {
    if (ldk == 0) ldk = K;
    const int nblk = Nd / 32;
    const int kb = it / nblk, db = it % nblk, k0 = 64 * kb, d0 = 32 * db;
    int sel; const int col = map(d0 + (lane & 31), sel);
    const float* W = sel ? W1 : W0;
    float v[32];
#pragma unroll
    for (int i = 0; i < 32; ++i) { const int kk = 2 * i + (lane >> 5); v[i] = (col >= 0) ? W[(size_t)(k0 + kk) * N + col] : 0.f; }
    if (kscale) {
#pragma unroll
        for (int i = 0; i < 32; ++i) v[i] *= kscale[k0 + 2 * i + (lane >> 5)];
    }
#pragma unroll
    for (int i = 0; i < 32; ++i) scr[(2 * i + (lane >> 5)) * 33 + (lane & 31)] = v[i];
    asm volatile("s_waitcnt lgkmcnt(0)" ::: "memory");
    const int c = lane & 7;
#pragma unroll
    for (int j = 0; j < 4; ++j) { const int n = (lane >> 3) + 8 * j; const LAS float* s = scr + (8 * c) * 33 + n;
        u32x4 o; o.x = pk2(s[0 * 33], s[1 * 33]); o.y = pk2(s[2 * 33], s[3 * 33]); o.z = pk2(s[4 * 33], s[5 * 33]); o.w = pk2(s[6 * 33], s[7 * 33]);
        *(u32x4*)(WT + (size_t)(d0 + n) * ldk + koff + k0 + 8 * c) = o; }
    asm volatile("s_waitcnt lgkmcnt(0)" ::: "memory");
}

struct Args { const float* in[17]; float* out; unsigned char* ws; };

__global__ void __launch_bounds__(NTHR, 2) fwd_kernel(Args a) {
    extern __shared__ __attribute__((aligned(16))) unsigned char lds_raw[];
    LAS unsigned char* lds = (LAS unsigned char*)lds_raw;
    const int tid = threadIdx.x, lane = tid & 63, wave = __builtin_amdgcn_readfirstlane(tid >> 6);
    const int G = gridDim.x, gw = blockIdx.x * NWAVES + wave, NGW = G * NWAVES;
    volatile LAS unsigned* lctl = (volatile LAS unsigned*)(lds + 131072);
    if (tid < 4) lctl[tid] = 0u;
    __syncthreads();
    XcdBarrier xbar = xcd_barrier_post((unsigned*)(a.ws + WS_CTL), lctl);
    unsigned char* ws = a.ws;
    const float* x = a.in[0];
    bf16_t* Win_t = (bf16_t*)(ws + WS_WIN); bf16_t* W1k_t = (bf16_t*)(ws + WS_W1K); bf16_t* W1v_t = (bf16_t*)(ws + WS_W1V);
    bf16_t* W2k_t = (bf16_t*)(ws + WS_W2K); bf16_t* W2v_t = (bf16_t*)(ws + WS_W2V); float* bias1 = (float*)(ws + WS_BIAS1);
    float* ropec = (float*)(ws + WS_ROPE); float* ropes = ropec + SEQ * 32;
    bf16_t* Wba_t = (bf16_t*)(ws + WS_WBA); bf16_t* Wbb_t = (bf16_t*)(ws + WS_WBB); bf16_t* Wo_t = (bf16_t*)(ws + WS_WO);
    bf16_t* Wgu_t = (bf16_t*)(ws + WS_WGU); bf16_t* Wd_t = (bf16_t*)(ws + WS_WD);
    bf16_t* XN = (bf16_t*)(ws + WS_XN); bf16_t* Z = (bf16_t*)(ws + WS_Z); bf16_t* ACT = (bf16_t*)(ws + WS_ACT);
    bf16_t* T1 = (bf16_t*)(ws + WS_T1); bf16_t* MG = (bf16_t*)(ws + WS_MG); bf16_t* HB = (bf16_t*)(ws + WS_HB);
    float* SS1 = (float*)(ws + WS_SS1); float* SS2 = (float*)(ws + WS_SS2);
    unsigned char* os = (unsigned char*)a.out;
    bf16_t* YA = (bf16_t*)(os + OS_YA); bf16_t* YB = YA;
    bf16_t* OCMP = (bf16_t*)(os + OS_OCMP); unsigned* DMASK = (unsigned*)(os + OS_DMASK); unsigned* SELM = (unsigned*)(os + OS_SELM);
    float* SC = (float*)(ws + WS_SC); bf16_t* KCC = (bf16_t*)(ws + WS_KCC); bf16_t* VCT = (bf16_t*)(ws + WS_VCT);
    unsigned* TASKTAB = (unsigned*)(ws + WS_BIAS1 + 4096);
    float* BPART = (float*)(ws + WS_BIAS1 + 16384);

#ifndef REP_P0
#define REP_P0 1
#endif
#ifndef REP_P1
#define REP_P1 1
#endif
#ifndef REP_P7
#define REP_P7 1
#endif
    for (int rep = 0; rep < REP_P0; ++rep) {
        LAS float* scr = (LAS float*)(lds + wave * 16384);
        {
            constexpr int I0 = (DM / 64) * (NZ / 32);
            for (int it0 = gw; it0 < I0; it0 += NGW) transpose_item(a.in[2], a.in[2], DIN, DM, NZ, nullptr, Win_t, MapInProj(), scr, it0, lane);
        }
        const float* gmix = a.in[1];
        for (int m = gw; m < MTOK; m += 4 * NGW) {
            f32x4 v[4][4]; float s[4];
#pragma unroll
            for (int q = 0; q < 4; ++q) { const int mq = (m + q * NGW < MTOK) ? m + q * NGW : m; const f32x4* xr = (const f32x4*)(x + (size_t)mq * DM) + lane;
#pragma unroll
                for (int j = 0; j < 4; ++j) v[q][j] = xr[64 * j]; }
#pragma unroll
            for (int q = 0; q < 4; ++q) { s[q] = 0.f;
#pragma unroll
                for (int j = 0; j < 4; ++j) s[q] += (v[q][j][0] * v[q][j][0] + v[q][j][1] * v[q][j][1]) + (v[q][j][2] * v[q][j][2] + v[q][j][3] * v[q][j][3]); }
#pragma unroll
            for (int o = 1; o < 64; o <<= 1) {
#pragma unroll
                for (int q = 0; q < 4; ++q) s[q] += __shfl_xor(s[q], o); }
            const f32x4* gr = (const f32x4*)gmix + lane;
#pragma unroll
            for (int q = 0; q < 4; ++q) if (m + q * NGW < MTOK) {
                const float rr = 1.0f / sqrtf(s[q] * (1.0f / DM) + EPS);
                u32x2* o8 = (u32x2*)(XN + (size_t)(m + q * NGW) * DM) + lane;
#pragma unroll
                for (int j = 0; j < 4; ++j) { const f32x4 g = gr[64 * j]; u32x2 w; w.x = pk2(v[q][j][0] * rr * g[0], v[q][j][1] * rr * g[1]); w.y = pk2(v[q][j][2] * rr * g[2], v[q][j][3] * rr * g[3]); o8[64 * j] = w; }
            }
        }
        for (int i = blockIdx.x * NTHR + tid; i < SEQ * 32; i += G * NTHR) {
            const int pos = i >> 5, j = i & 31; const float inv = powf(10000.0f, -(float)j / 32.0f); const float ang = (float)pos * inv;
            ropec[i] = cosf(ang); ropes[i] = sinf(ang);
        }
        for (int o = NGW - 1 - gw; o < 256; o += NGW) {
            const int kv = o >> 7, jb = (o >> 5) & 3, kc = o & 31; const float* pos = a.in[kv ? 6 : 3]; const float* w1 = a.in[kv ? 7 : 4]; float s = 0.f;
#pragma unroll 8
            for (int k = 0; k < 64; ++k) s += pos[kc * 64 + k] * w1[(size_t)(kc * 64 + k) * 256 + jb * 64 + lane];
            BPART[kc * 512 + kv * 256 + jb * 64 + lane] = s;
        }
        if (gw == NGW - 1 - 256 || (NGW <= 256 && gw == 0)) {
            for (int k = lane; k < 96; k += 64) {
                const int cost = k < 32 ? 7 * ((k + 1) + (k + 1 < 9 ? k + 1 : 9)) : 6 * (((k - 32) >> 1) + 1), cnt = k < 32 ? 32 : 16; int pos = 0;
                for (int k2 = 0; k2 < 96; ++k2) { const int c2 = k2 < 32 ? 7 * ((k2 + 1) + (k2 + 1 < 9 ? k2 + 1 : 9)) : 6 * (((k2 - 32) >> 1) + 1), n2 = k2 < 32 ? 32 : 16;
                    if (c2 > cost || (c2 == cost && k2 < k)) pos += n2; }
                for (int bb = 0; bb < cnt; ++bb) TASKTAB[pos + bb] = (unsigned)k | ((unsigned)bb << 8);
            }
        }
    }
    xcd_barrier(xbar);
    if (blockIdx.x == 0) { float s = 0.f; for (int kc = 0; kc < 32; ++kc) s += BPART[kc * 512 + tid]; bias1[tid] = s; }
    for (int rep = 0; rep < REP_P1; ++rep) { pg8::Gemm g{XN, Win_t, MTOK, NZ, DM}; pg8::StaticOrder S; S.init(MTOK, NZ, G, (int)blockIdx.x); EpiInProj E{Z, ropec, ropes}; pg8::gemm_phase(lds, g, S, E); }
    {
        const int nunits = (MTOK / 256) * (NZ / 256), rem = nunits % G;
        const int nhelp = rem ? G - rem : G, hid = rem ? (int)blockIdx.x - rem : (int)blockIdx.x;
        if (hid >= 0) {
            LAS float* scr = (LAS float*)(lds + wave * 16384);
            constexpr int I1 = 32 * 8, I3 = 4 * 2, I5 = 8 * 32, I7 = 16 * 32, I8 = 16 * (NGU / 32), I9 = (DFF / 64) * 32;
            constexpr int NIT2 = 2 * I1 + 2 * I3 + 2 * I5 + I7 + I8 + I9;
            for (int it0 = hid * NWAVES + wave; it0 < NIT2; it0 += nhelp * NWAVES) {
                int r = it0;
                if (r < I8) { transpose_item(a.in[13], a.in[14], DFF, DM, NGU, a.in[12], Wgu_t, MapGU(), scr, r, lane); continue; } r -= I8;
                if (r < I9) { transpose_item(a.in[15], a.in[15], DM, DFF, DM, nullptr, Wd_t, MapIdent(), scr, r, lane); continue; } r -= I9;
                if (r < I7) { transpose_item(a.in[11], a.in[11], DM, DM, DM, nullptr, Wo_t, MapIdent(), scr, r, lane); continue; } r -= I7;
                if (r < I5) { transpose_item(a.in[9], a.in[9], DM, 512, DM, nullptr, Wba_t, MapIdent(), scr, r, lane, 1024, 0); continue; } r -= I5;
                if (r < I5) { transpose_item(a.in[10], a.in[10], DM, 512, DM, nullptr, Wba_t, MapIdent(), scr, r, lane, 1024, 512); continue; } r -= I5;
                if (r < I1) { transpose_item(a.in[4], a.in[4], 256, 2048, 256, nullptr, W1k_t, MapIdent(), scr, r, lane); continue; } r -= I1;
                if (r < I1) { transpose_item(a.in[7], a.in[7], 256, 2048, 256, nullptr, W1v_t, MapIdent(), scr, r, lane); continue; } r -= I1;
                if (r < I3) { transpose_item(a.in[5], a.in[5], 64, 256, 64, nullptr, W2k_t, MapIdent(), scr, r, lane); continue; } r -= I3;
                transpose_item(a.in[8], a.in[8], 64, 256, 64, nullptr, W2v_t, MapIdent(), scr, r, lane);
            }
        }
    }
    xcd_barrier(xbar);
#ifndef REP_P2
#define REP_P2 1
#endif
#define REP_P2A 1
#define REP_P2B 1
#define REP_P3A 1
#define REP_P3B 1
#ifndef REP_P3
#define REP_P3 1
#endif
    for (int rep = 0; rep < REP_P2; ++rep) {
    for (int rp = 0; rp < REP_P2A; ++rp)
    if (EN_SLC || EN_CMP) for (int task = blockIdx.x; task < 256; task += G) { const int kv = task >> 7;
        compress_task(lds, Z, kv ? W1v_t : W1k_t, kv ? W2v_t : W2k_t, bias1, KCC, VCT, kv, (task >> 3) & 15, (task >> 2) & 1, task & 3, tid, wave, lane); }
    for (int rp = 0; rp < REP_P2B; ++rp)
    if (EN_DSA) { const int per = (33280 + NGW - 1) / NGW; const int i0 = gw * per, i1 = (i0 + per < 33280) ? i0 + per : 33280; score_range(Z, SC, i0, i1, lane); }
    }
    xcd_barrier(xbar);
    {
        const int nrow = (MTOK - gw + NGW - 1) / NGW, ncmp = (8192 - gw + NGW - 1) / NGW;
        const int stride = nrow > 0 && ncmp > 0 ? (nrow / ncmp > 0 ? nrow / ncmp : 1) : 1, phase = ((wave >> 2) * (stride >> 1) + (wave & 1)) % stride;
        int ci = 0;
        for (int i = 0; i < nrow || ci < ncmp; ++i) {
            if (ci < ncmp && (i >= nrow || (i % stride) == phase)) { const int task = gw + ci * NGW; ++ci;
                cmp_task(Z, KCC, VCT, OCMP, SELM, task >> 9, (task >> 8) & 1, (task + 64 * (task >> 11)) & 255, lane); }
            if (i < nrow) { const int r = gw + i * NGW; select_row(SC, DMASK, r & 15, r >> 4, lane); }
        }
    }
    xcd_barrier(xbar);
#ifndef REP_P4
#define REP_P4 1
#endif
    for (int rep = 0; rep < REP_P4; ++rep)
    for (int r = 0; r * G < 2048; ++r) {
        const int idx = r * G + ((r & 1) ? G - 1 - (int)blockIdx.x : (int)blockIdx.x);
        if (idx >= 2048) continue;
        const unsigned e = TASKTAB[idx]; const int k = (int)(e & 255u), bb = (int)(e >> 8);
        int tid_ = threadIdx.x; asm volatile("" : "+v"(tid_));
        const int lane_ = tid_ & 63;
        if (k < 32) { if (EN_WIN || EN_SLC || EN_CMP) nsa_task(lds, Z, SELM, OCMP, YA, bb >> 1, bb & 1, k, tid_, wave, lane_); }
        else { if (EN_DSA) dsa_task(lds, Z, DMASK, YB, bb, k - 32, tid_, wave, lane_); }
    }
    xcd_barrier(xbar);
    { pg8::Gemm g{YA, Wba_t, MTOK, DM, DM}; pg8::StaticOrder S; S.init(MTOK, DM, G, (int)blockIdx.x); EpiMerge E{Z, MG}; pg8::gemm_phase<EpiMerge, true>(lds, g, S, E); }
    xcd_barrier(xbar);
    { pg8::Gemm g{MG, Wo_t, MTOK, DM, DM}; pg8::StaticOrder S; S.init(MTOK, DM, G, (int)blockIdx.x); EpiResid<1> E{x, nullptr, nullptr, HB, SS1}; pg8::gemm_phase(lds, g, S, E); }
    xcd_barrier(xbar);
    for (int rep = 0; rep < REP_P7; ++rep) { pg8::Gemm g{HB, Wgu_t, MTOK, NGU, DM}; pg8::StaticOrder S; S.init(MTOK, NGU, G, (int)blockIdx.x); EpiGU E{SS1, ACT}; pg8::gemm_phase(lds, g, S, E); }
    xcd_barrier(xbar);
    { pg8::Gemm g{ACT, Wd_t, MTOK, DM, DFF}; pg8::StaticOrder S; S.init(MTOK, DM, G, (int)blockIdx.x);
      EpiDownNorm E{HB, a.out, a.in[16], (unsigned*)SS2, (unsigned*)(a.ws + WS_CTL) + 4096, lds + 131072 + 256}; pg8::gemm_phase(lds, g, S, E); }
}

extern "C" void kernel_launch(void* const* d_in, const int* in_sizes, int n_in, void* d_out, int out_size, void* d_ws, size_t ws_size, hipStream_t stream) {
    static int grid = 0;
    if (grid == 0) {
        int dev = 0, cus = 0, per_cu = 0;
        hipGetDevice(&dev);
        hipDeviceGetAttribute(&cus, hipDeviceAttributeMultiprocessorCount, dev);
        hipFuncSetAttribute((const void*)fwd_kernel, hipFuncAttributeMaxDynamicSharedMemorySize, LDS_BYTES);
        hipOccupancyMaxActiveBlocksPerMultiprocessor(&per_cu, (const void*)fwd_kernel, NTHR, LDS_BYTES);
        if (per_cu < 1) { fprintf(stderr, "occupancy query says %d\n", per_cu); per_cu = 1; }
        if (per_cu > 1) per_cu = 1;
        grid = cus * per_cu;
        if (n_in != 17 || ws_size < WS_END) { fprintf(stderr, "unexpected n_in %d / ws_size %zu\n", n_in, ws_size); }
    }
    hipMemsetAsync((char*)d_ws + WS_CTL, 0, 65536, stream);
    Args a{};
    for (int i = 0; i < 17; ++i) a.in[i] = (const float*)d_in[i];
    a.out = (float*)d_out; a.ws = (unsigned char*)d_ws;
    void* args[] = {&a};
    hipError_t e = hipLaunchCooperativeKernel((const void*)fwd_kernel, dim3(grid), dim3(NTHR), args, LDS_BYTES, stream);
    if (e != hipSuccess) fprintf(stderr, "cooperative launch failed: %s (grid %d)\n", hipGetErrorString(e), grid);
}
```

```cpp
#include <hip/hip_runtime.h>
#include <hip/hip_cooperative_groups.h>
#include <cstdio>
#include <cstdint>
namespace cg = cooperative_groups;

#define LAS __attribute__((address_space(3)))
#define DI __device__ __forceinline__
typedef unsigned short bf16_t;
typedef short bf16x8 __attribute__((ext_vector_type(8)));
typedef short s16x4 __attribute__((ext_vector_type(4)));
typedef float f32x4 __attribute__((ext_vector_type(4)));
typedef float f32x2 __attribute__((ext_vector_type(2)));
typedef float f32x16 __attribute__((ext_vector_type(16)));
typedef unsigned u32x4 __attribute__((ext_vector_type(4)));
typedef unsigned u32x2 __attribute__((ext_vector_type(2)));

constexpr int BATCH = 16, SEQ = 2048, DM = 1024, MTOK = BATCH * SEQ;
constexpr int DIN = 4316, NZ = 4352, DFF = 2816, NGU = 2 * DFF;
constexpr float EPS = 1e-6f;
constexpr int ZC_QA = 0, ZC_KC = 512, ZC_KS = 640, ZC_KW = 768, ZC_QB = 896, ZC_KB = 1408, ZC_IQ = 1472, ZC_IK = 1728;
constexpr int ZC_VC = 1792, ZC_VS = 1920, ZC_VW = 2048, ZC_VB = 2176, ZC_GA = 2240, ZC_IW = 2264, ZC_GM = 2304;
constexpr size_t MiB = 1u << 20;
constexpr size_t WS_WIN = 0, WS_W1K = 9 * MiB, WS_W1V = 10 * MiB, WS_W2K = 11 * MiB, WS_W2V = 11 * MiB + 65536, WS_BIAS1 = 11 * MiB + 131072,
                 WS_ROPE = 11 * MiB + 524288, WS_WBA = 12 * MiB, WS_WBB = 13 * MiB, WS_WO = 14 * MiB, WS_WGU = 16 * MiB, WS_WD = 27 * MiB;
constexpr size_t WS_A = 34 * MiB;
constexpr size_t WS_XN = WS_A, WS_SC = WS_A, WS_T1 = WS_A, WS_MG = WS_A + 64 * MiB, WS_HB = WS_A + 128 * MiB;
constexpr size_t WS_Z = 226 * MiB, WS_ACT = WS_Z;
constexpr size_t WS_KCC = 498 * MiB, WS_VCT = 498 * MiB + 524288, WS_SS1 = 499 * MiB, WS_SS2 = 501 * MiB, WS_CTL = 503 * MiB, WS_END = 504 * MiB;
constexpr size_t OS_OCMP = 0, OS_YA = 32 * MiB, OS_YB = 64 * MiB, OS_DMASK = 96 * MiB, OS_SELM = 104 * MiB;

constexpr int NWAVES = 8, NTHR = 512;
constexpr int LDS_BYTES = 147456;

DI unsigned f2bf(float f) { unsigned u = __builtin_bit_cast(unsigned, f); return (u + 0x7fffu + ((u >> 16) & 1u)) >> 16; }
typedef __bf16 bf16x2_t __attribute__((ext_vector_type(2)));
DI unsigned pk2(float lo, float hi) { const f32x2 v = {lo, hi}; const bf16x2_t b = __builtin_convertvector(v, bf16x2_t); return __builtin_bit_cast(unsigned, b); }
DI float bf2f(unsigned short b) { return __builtin_bit_cast(float, (unsigned)b << 16); }
DI float bflo(unsigned w) { return __builtin_bit_cast(float, w << 16); }
DI float bfhi(unsigned w) { return __builtin_bit_cast(float, w & 0xffff0000u); }
DI float sigmoidf_(float x) { return __builtin_amdgcn_rcpf(1.0f + __expf(-x)); }
DI float wave_sum(float v) {
#pragma unroll
    for (int o = 1; o < 64; o <<= 1) v += __shfl_xor(v, o);
    return v;
}


#define XB_TMO      128
#define XB_XCNT(j)  (256  + 64 * (j))
#define XB_XSUB(j)  (1280 + 64 * (j))
#define XB_XGEN(j)  (2304 + 64 * (j))
#define XB_TOP      3328
#define XB_TOPGEN   3392
#define XCD_BAR_WORDS 3456
#define XB_SPIN_CAP (1u << 22)
DI unsigned xb_ld(unsigned* p)              { return __hip_atomic_load(p, __ATOMIC_RELAXED, __HIP_MEMORY_SCOPE_AGENT); }
DI unsigned xb_add(unsigned* p, unsigned v) { return __hip_atomic_fetch_add(p, v, __ATOMIC_RELAXED, __HIP_MEMORY_SCOPE_AGENT); }
DI unsigned xb_xcc_id() { return (unsigned)__builtin_amdgcn_s_getreg((3 << 11) | 20) & 0xFu; }
#define XB_SPIN(cond, bar) do { unsigned _sp = 0; while (cond) { __builtin_amdgcn_s_sleep(1); \
    if ((++_sp & 255u) == 0u) { if (xb_ld(&(bar)[XB_TMO])) break; if (_sp > XB_SPIN_CAP) { atomicAdd(&(bar)[XB_TMO], 1u); break; } } } } while (0)
struct XcdBarrier { unsigned* bar; unsigned x; volatile LAS unsigned* st; };
DI XcdBarrier xcd_barrier_post(unsigned* bar, volatile LAS unsigned* st) {
    XcdBarrier b; b.bar = bar; b.x = xb_xcc_id(); b.st = st;
    if (threadIdx.x == 0) (void)xb_add(&bar[XB_XCNT(b.x)], 1u);
    return b;
}
DI void xcd_barrier_complete(unsigned* bar, unsigned x, unsigned& nloc, unsigned& nx) {
    const unsigned G = gridDim.x * gridDim.y * gridDim.z;
    unsigned sum, cnt, mine, sp = 0u;
    for (;;) {
        sum = 0u; cnt = 0u; mine = 0u;
#pragma unroll
        for (unsigned j = 0; j < 16; ++j) { const unsigned c = xb_ld(&bar[XB_XCNT(j)]); sum += c; cnt += (c > 0u) ? 1u : 0u; mine = (j == x) ? c : mine; }
        if (sum == G) break;
        __builtin_amdgcn_s_sleep(1);
        if ((++sp & 255u) == 0u) { if (xb_ld(&bar[XB_TMO])) break; if (sp > XB_SPIN_CAP) { atomicAdd(&bar[XB_TMO], 1u); break; } }
    }
    nloc = mine > 0u ? mine : 1u; nx = cnt > 0u ? cnt : 1u;
}
DI void xcd_barrier(const XcdBarrier& b) {
    asm volatile("s_waitcnt vmcnt(0)" ::: "memory");
    __syncthreads();
    if (threadIdx.x == 0) {
        unsigned* bar = b.bar;
        __builtin_amdgcn_s_waitcnt(0);
        unsigned nloc = b.st[0], nx = b.st[1];
        if (nloc == 0u) { xcd_barrier_complete(bar, b.x, nloc, nx); b.st[0] = nloc; b.st[1] = nx; }
        const unsigned old = xb_add(&bar[XB_XSUB(b.x)], 1u);
        const unsigned gen = old / nloc;
        if (old + 1u == (gen + 1u) * nloc) {
            __builtin_amdgcn_fence(__ATOMIC_RELEASE, "agent");
            asm volatile("s_waitcnt vmcnt(0)" ::: "memory");
            const unsigned og = xb_add(&bar[XB_TOP], 1u);
            const unsigned tg = og / nx;
            if (og + 1u == (tg + 1u) * nx) xb_add(&bar[XB_TOPGEN], 1u);
            else XB_SPIN(xb_ld(&bar[XB_TOPGEN]) == tg, bar);
            __builtin_amdgcn_fence(__ATOMIC_ACQUIRE, "agent");
            xb_add(&bar[XB_XGEN(b.x)], 1u);
            asm volatile("s_waitcnt vmcnt(0)" ::: "memory");
        } else {
            XB_SPIN(xb_ld(&bar[XB_XGEN(b.x)]) == gen, bar);
            __builtin_amdgcn_fence(__ATOMIC_ACQUIRE, "agent");
            asm volatile("s_waitcnt vmcnt(0)" ::: "memory");
        }
    }
    __syncthreads();
}

namespace pg8 {
constexpr int BM = 256, BK = 64, HALF = 128, HTB = HALF * BK * 2, STAGE_BYTES = 8 * HTB, NXCD = 8, WGM = 8;
DI int lds_byte(int r, int c) { const int st = (r >> 4) * 2 + (c >> 5), rr = r & 15, cc = c & 31, ob = rr * 64 + cc * 2; return st * 1024 + (ob ^ (((ob >> 9) & 1) << 5)); }
DI void stage_rc(int b, int& R, int& C) { const int st = b / 1024, sb = b % 1024, swz = sb ^ (((sb >> 9) & 1) << 5); R = (st >> 1) * 16 + swz / 64; C = (st & 1) * 32 + (swz % 64) / 2; }
DI int perm32(int rho) { const int n = rho >> 4, i = rho & 15; return 8 * (i >> 2) + 4 * n + (i & 3); }
struct Unit { int pm, pn; };
struct Gemm { const bf16_t* A; const bf16_t* Bt; int M, N, K; };
struct StaticOrder {
    int nM, nN, nwg, G, c;
    DI void init(int M, int N, int G_, int c_) { nM = M / BM; nN = N / BM; nwg = nM * nN; G = G_; c = c_; }
    DI bool next(int i, Unit& u) const {
        const long L = (long)i * G + c; if (L >= nwg) return false;
        int wgid = (int)L; { const int q = nwg / NXCD, r = nwg % NXCD, xcd = wgid % NXCD, off = wgid / NXCD; wgid = (xcd < r ? xcd * (q + 1) : r * (q + 1) + (xcd - r) * q) + off; }
        const int nig = WGM * nN, gid = wgid / nig, fm = gid * WGM, gsz = (nM - fm) < WGM ? (nM - fm) : WGM;
        u.pm = fm + ((wgid % nig) % gsz); u.pn = (wgid % nig) / gsz; return true;
    }
};
template <class Epi, bool HOOK = false>
DI void gemm_phase(LAS unsigned char* lds, const Gemm g, const StaticOrder& S, const Epi& E) {
    int tid = threadIdx.x; asm volatile("" : "+v"(tid));
    const int wid = __builtin_amdgcn_readfirstlane(tid >> 6), lane = tid & 63, wr = wid >> 2, wc = wid & 3, fr = lane & 15, fq = lane >> 4;
    const int K = g.K, nt = K / BK;
    unsigned voffA[2], voffB[2];
#pragma unroll
    for (int i = 0; i < 2; ++i) { int R, C; stage_rc(tid * 16 + i * 8192, R, C); const int Rb = (R & ~31) + perm32(R & 31);
        voffA[i] = (unsigned)(R * K + C) * 2u; voffB[i] = (unsigned)(Rb * K + C) * 2u; }
    const size_t kstep = (size_t)(BK * 2);
    const size_t hstep = (size_t)HALF * K * 2;
    const size_t tstep = 2 * hstep;
    const unsigned ldsw = (unsigned)wid * 1024u;
    const int aoff = lds_byte(wr * 64 + fr, fq * 8), boff = lds_byte(wc * 32 + fr, fq * 8);
#define PG8_SA(b, h) (((b) * 2 + (h)) * HTB)
#define PG8_SB(b, h) ((4 + (b) * 2 + (h)) * HTB)
#define PG8_STAGE(bufoff, gbase, voff) do { _Pragma("unroll") for (int _i = 0; _i < 2; ++_i) \
        __builtin_amdgcn_global_load_lds((const unsigned*)((const char*)(gbase) + (voff)[_i]), (LAS unsigned*)(lds + (bufoff) + ldsw + _i * 8192), 16, 0, 0); } while (0)
#define PG8_LDA(dst, b, h) do { _Pragma("unroll") for (int m = 0; m < 4; ++m) _Pragma("unroll") for (int k = 0; k < 2; ++k) dst[m][k] = *(const LAS bf16x8*)(lds + PG8_SA(b, h) + aoff + m * 2048 + k * 1024); } while (0)
#define PG8_LDB(dst, b, h) do { _Pragma("unroll") for (int n = 0; n < 2; ++n) _Pragma("unroll") for (int k = 0; k < 2; ++k) dst[n][k] = *(const LAS bf16x8*)(lds + PG8_SB(b, h) + boff + n * 2048 + k * 1024); } while (0)
#define PG8_MMA(ai, bj, At, Bt) do { __builtin_amdgcn_s_setprio(1); _Pragma("unroll") for (int m = 0; m < 4; ++m) _Pragma("unroll") for (int n = 0; n < 2; ++n) _Pragma("unroll") for (int k = 0; k < 2; ++k) \
        acc[ai][bj][m][n] = __builtin_amdgcn_mfma_f32_16x16x32_bf16(Bt[n][k], At[m][k], acc[ai][bj][m][n], 0, 0, 0); __builtin_amdgcn_s_setprio(0); } while (0)
#define PG8_WAIT_V(n) asm volatile("s_waitcnt vmcnt(" #n ")" ::: "memory")
#define PG8_WAIT_L(n) asm volatile("s_waitcnt lgkmcnt(" #n ")" ::: "memory")
#define PG8_BAR __builtin_amdgcn_s_barrier()
#define PG8_SCHED __builtin_amdgcn_sched_barrier(0)
    Unit cur, nxt; int ui = 0;
    if (!S.next(0, cur)) return;
    f32x4 acc[2][2][4][2];
#pragma unroll
    for (int a = 0; a < 2; ++a)
#pragma unroll
        for (int b = 0; b < 2; ++b)
#pragma unroll
            for (int m = 0; m < 4; ++m)
#pragma unroll
                for (int n = 0; n < 2; ++n) acc[a][b][m][n] = (f32x4){0.f, 0.f, 0.f, 0.f};
    bf16x8 At[4][2], B0[2][2], B1[2][2];
    const char* cA = (const char*)g.A + (size_t)cur.pm * tstep; const char* cB = (const char*)g.Bt + (size_t)cur.pn * tstep;
    PG8_STAGE(PG8_SB(0, 0), cB, voffB); PG8_STAGE(PG8_SB(0, 1), cB + hstep, voffB); PG8_STAGE(PG8_SA(0, 0), cA, voffA); PG8_STAGE(PG8_SA(0, 1), cA + hstep, voffA);
    if (wr == 1) PG8_BAR;
    PG8_WAIT_V(2); PG8_BAR;
    PG8_STAGE(PG8_SB(1, 0), cB + kstep, voffB); PG8_STAGE(PG8_SA(1, 0), cA + kstep, voffA); PG8_STAGE(PG8_SB(1, 1), cB + hstep + kstep, voffB);
    PG8_WAIT_V(6); PG8_BAR;
    for (;;) {
        const bool has_next = S.next(ui + 1, nxt);
        const char* nA = has_next ? (const char*)g.A + (size_t)nxt.pm * tstep : cA; const char* nB = has_next ? (const char*)g.Bt + (size_t)nxt.pn * tstep : cB;
#define PG8_KBODY() do { \
            const bool last = (t == nt - 2); \
            const char* a1 = cA + (size_t)(t + 1) * kstep; \
            const char* a2 = last ? nA : cA + (size_t)(t + 2) * kstep; const char* b2 = last ? nB : cB + (size_t)(t + 2) * kstep; \
            const char* a3 = a2 + kstep; const char* b3 = b2 + kstep; \
            PG8_LDB(B0, 0, 0); PG8_LDB(B1, 0, 1); PG8_SCHED; PG8_LDA(At, 0, 0); PG8_STAGE(PG8_SA(1, 1), a1 + hstep, voffA); \
            PG8_WAIT_V(8); PG8_WAIT_L(0); PG8_BAR; PG8_MMA(0, 0, At, B0); PG8_MMA(0, 1, At, B1); PG8_BAR; PG8_SCHED; \
            PG8_LDA(At, 0, 1); PG8_STAGE(PG8_SB(0, 0), b2, voffB); PG8_STAGE(PG8_SB(0, 1), b2 + hstep, voffB); PG8_STAGE(PG8_SA(0, 0), a2, voffA); \
            PG8_WAIT_V(8); PG8_WAIT_L(0); PG8_BAR; PG8_MMA(1, 0, At, B0); PG8_MMA(1, 1, At, B1); PG8_BAR; PG8_SCHED; \
            PG8_LDB(B0, 1, 0); PG8_LDB(B1, 1, 1); PG8_SCHED; PG8_LDA(At, 1, 0); PG8_STAGE(PG8_SA(0, 1), a2 + hstep, voffA); \
            PG8_WAIT_V(8); PG8_WAIT_L(0); PG8_BAR; PG8_MMA(0, 0, At, B0); PG8_MMA(0, 1, At, B1); PG8_BAR; PG8_SCHED; \
            PG8_LDA(At, 1, 1); PG8_STAGE(PG8_SB(1, 0), b3, voffB); PG8_STAGE(PG8_SB(1, 1), b3 + hstep, voffB); PG8_STAGE(PG8_SA(1, 0), a3, voffA); \
            PG8_WAIT_V(8); PG8_WAIT_L(0); PG8_BAR; PG8_MMA(1, 0, At, B0); PG8_MMA(1, 1, At, B1); PG8_BAR; PG8_SCHED; \
        } while (0)
        if constexpr (HOOK) {
            for (int t = 0; t < (nt >> 1); t += 2) PG8_KBODY();
            E.hook(acc, cur, wr, wc, fr, fq);
            for (int t = (nt >> 1); t < nt; t += 2) PG8_KBODY();
        } else {
            for (int t = 0; t < nt; t += 2) PG8_KBODY();
        }
#undef PG8_KBODY
        if (wr == 0) PG8_BAR;
        E(acc, cur, wr, wc, fr, fq);
        if (!has_next) break;
#pragma unroll
        for (int a = 0; a < 2; ++a)
#pragma unroll
            for (int b = 0; b < 2; ++b)
#pragma unroll
                for (int m = 0; m < 4; ++m)
#pragma unroll
                    for (int n = 0; n < 2; ++n) acc[a][b][m][n] = (f32x4){0.f, 0.f, 0.f, 0.f};
        cur = nxt; cA = nA; cB = nB; ++ui;
        if (wr == 1) PG8_BAR;
    }
    PG8_WAIT_V(0);
    PG8_BAR;
#undef PG8_SA
#undef PG8_SB
#undef PG8_STAGE
#undef PG8_LDA
#undef PG8_LDB
#undef PG8_MMA
#undef PG8_WAIT_V
#undef PG8_WAIT_L
#undef PG8_BAR
#undef PG8_SCHED
}
}
using pg8::Unit;
typedef f32x4 Acc[2][2][4][2];

struct EpiInProj {
    bf16_t* Z; const float* ropec; const float* ropes;
    DI void operator()(const Acc& acc, const Unit& u, int wr, int wc, int fr, int fq) const {
        const int row0 = u.pm * 256 + wr * 64 + fr;
        if (u.pn < 7) {
            const int jj = 16 * (wc & 1) + 4 * fq;
#pragma unroll
            for (int ai = 0; ai < 2; ++ai)
#pragma unroll
                for (int m = 0; m < 4; ++m) {
                    const int r = row0 + ai * 128 + m * 16; const int pos = r & (SEQ - 1);
                    const f32x4 c = *(const f32x4*)(ropec + pos * 32 + jj), s = *(const f32x4*)(ropes + pos * 32 + jj);
#pragma unroll
                    for (int bj = 0; bj < 2; ++bj) {
                        const f32x4 x1 = acc[ai][bj][m][0], x2 = acc[ai][bj][m][1];
                        const f32x4 o1 = x1 * c - x2 * s, o2 = x1 * s + x2 * c;
                        bf16_t* p = Z + (size_t)r * NZ + u.pn * 256 + bj * 128 + (wc >> 1) * 64 + jj;
                        u32x2 w1; w1.x = pk2(o1[0], o1[1]); w1.y = pk2(o1[2], o1[3]);
                        u32x2 w2; w2.x = pk2(o2[0], o2[1]); w2.y = pk2(o2[2], o2[3]);
                        *(u32x2*)p = w1; *(u32x2*)(p + 32) = w2;
                    }
                }
        } else {
#pragma unroll
            for (int ai = 0; ai < 2; ++ai)
#pragma unroll
                for (int m = 0; m < 4; ++m) {
                    const int r = row0 + ai * 128 + m * 16;
#pragma unroll
                    for (int bj = 0; bj < 2; ++bj) {
                        const f32x4 v0 = acc[ai][bj][m][0], v1 = acc[ai][bj][m][1];
                        u32x4 w; w.x = pk2(v0[0], v0[1]); w.y = pk2(v0[2], v0[3]); w.z = pk2(v1[0], v1[1]); w.w = pk2(v1[2], v1[3]);
                        *(u32x4*)(Z + (size_t)r * NZ + u.pn * 256 + bj * 128 + wc * 32 + 8 * fq) = w;
                    }
                }
        }
    }
};
template <int SECOND> struct EpiGate {
    const bf16_t* Z; bf16_t* T1; bf16_t* MG;
    DI void operator()(const Acc& acc, const Unit& u, int wr, int wc, int fr, int fq) const {
        const int row0 = u.pm * 256 + wr * 64 + fr;
#pragma unroll
        for (int ai = 0; ai < 2; ++ai)
#pragma unroll
            for (int m = 0; m < 4; ++m) {
                const int r = row0 + ai * 128 + m * 16;
#pragma unroll
                for (int bj = 0; bj < 2; ++bj) {
                    const int c0 = u.pn * 256 + bj * 128 + wc * 32 + 8 * fq;
                    const u32x4 gw = *(const u32x4*)(Z + (size_t)r * NZ + ZC_GM + SECOND * DM + c0);
                    const f32x4 v0 = acc[ai][bj][m][0], v1 = acc[ai][bj][m][1];
                    float o[8];
                    o[0] = v0[0] * sigmoidf_(bflo(gw.x)); o[1] = v0[1] * sigmoidf_(bfhi(gw.x)); o[2] = v0[2] * sigmoidf_(bflo(gw.y)); o[3] = v0[3] * sigmoidf_(bfhi(gw.y));
                    o[4] = v1[0] * sigmoidf_(bflo(gw.z)); o[5] = v1[1] * sigmoidf_(bfhi(gw.z)); o[6] = v1[2] * sigmoidf_(bflo(gw.w)); o[7] = v1[3] * sigmoidf_(bfhi(gw.w));
                    if (SECOND) {
                        const u32x4 t = *(const u32x4*)(T1 + (size_t)r * DM + c0);
                        o[0] += bflo(t.x); o[1] += bfhi(t.x); o[2] += bflo(t.y); o[3] += bfhi(t.y); o[4] += bflo(t.z); o[5] += bfhi(t.z); o[6] += bflo(t.w); o[7] += bfhi(t.w);
                    }
                    u32x4 w; w.x = pk2(o[0], o[1]); w.y = pk2(o[2], o[3]); w.z = pk2(o[4], o[5]); w.w = pk2(o[6], o[7]);
                    *(u32x4*)((SECOND ? MG : T1) + (size_t)r * DM + c0) = w;
                }
            }
    }
};
struct EpiMerge {
    const bf16_t* Z; bf16_t* MG;
    DI void hook(Acc& acc, const Unit& u, int wr, int wc, int fr, int fq) const {
        const int row0 = u.pm * 256 + wr * 64 + fr;
#pragma unroll
        for (int ai = 0; ai < 2; ++ai)
#pragma unroll
            for (int m = 0; m < 4; ++m) {
                const int r = row0 + ai * 128 + m * 16;
#pragma unroll
                for (int bj = 0; bj < 2; ++bj) {
                    const int c0 = u.pn * 256 + bj * 128 + wc * 32 + 8 * fq;
                    const u32x4 ga = *(const u32x4*)(Z + (size_t)r * NZ + ZC_GM + c0), gb = *(const u32x4*)(Z + (size_t)r * NZ + ZC_GM + DM + c0);
                    float ra[8];
                    const unsigned gaw[4] = {ga.x, ga.y, ga.z, ga.w}, gbw[4] = {gb.x, gb.y, gb.z, gb.w};
#pragma unroll
                    for (int q = 0; q < 4; ++q) {
                        ra[2 * q] = (1.0f + __expf(-bflo(gbw[q]))) * __builtin_amdgcn_rcpf(1.0f + __expf(-bflo(gaw[q])));
                        ra[2 * q + 1] = (1.0f + __expf(-bfhi(gbw[q]))) * __builtin_amdgcn_rcpf(1.0f + __expf(-bfhi(gaw[q])));
                    }
                    acc[ai][bj][m][0] = acc[ai][bj][m][0] * (f32x4){ra[0], ra[1], ra[2], ra[3]};
                    acc[ai][bj][m][1] = acc[ai][bj][m][1] * (f32x4){ra[4], ra[5], ra[6], ra[7]};
                }
                asm volatile("" ::: "memory");
            }
    }
    DI void operator()(const Acc& acc, const Unit& u, int wr, int wc, int fr, int fq) const {
        int row0 = u.pm * 256 + wr * 64 + fr; asm volatile("" : "+v"(row0));
#pragma unroll
        for (int ai = 0; ai < 2; ++ai)
#pragma unroll
            for (int m = 0; m < 4; ++m) {
                const int r = row0 + ai * 128 + m * 16;
#pragma unroll
                for (int bj = 0; bj < 2; ++bj) {
                    const int c0 = u.pn * 256 + bj * 128 + wc * 32 + 8 * fq;
                    const u32x4 gw = *(const u32x4*)(Z + (size_t)r * NZ + ZC_GM + DM + c0);
                    const f32x4 v0 = acc[ai][bj][m][0], v1 = acc[ai][bj][m][1];
                    u32x4 w;
                    w.x = pk2(v0[0] * sigmoidf_(bflo(gw.x)), v0[1] * sigmoidf_(bfhi(gw.x))); w.y = pk2(v0[2] * sigmoidf_(bflo(gw.y)), v0[3] * sigmoidf_(bfhi(gw.y)));
                    w.z = pk2(v1[0] * sigmoidf_(bflo(gw.z)), v1[1] * sigmoidf_(bfhi(gw.z))); w.w = pk2(v1[2] * sigmoidf_(bflo(gw.w)), v1[3] * sigmoidf_(bfhi(gw.w)));
                    *(u32x4*)(MG + (size_t)r * DM + c0) = w;
                }
            }
    }
};
template <int MODE> struct EpiResid {
    const float* base; const bf16_t* baseb; float* H; bf16_t* HB; float* SS;
    DI void operator()(const Acc& acc, const Unit& u, int wr, int wc, int fr, int fq) const {
        const int row0 = u.pm * 256 + wr * 64 + fr;
#pragma unroll
        for (int ai = 0; ai < 2; ++ai)
#pragma unroll
            for (int m = 0; m < 4; ++m) {
                const int r = row0 + ai * 128 + m * 16; float ss = 0.f;
#pragma unroll
                for (int bj = 0; bj < 2; ++bj) {
                    const int c0 = u.pn * 256 + bj * 128 + wc * 32 + 8 * fq; const size_t off = (size_t)r * DM + c0;
                    f32x4 b0, b1;
                    if (MODE == 1) { b0 = *(const f32x4*)(base + off); b1 = *(const f32x4*)(base + off + 4); }
                    else { const u32x4 w = *(const u32x4*)(baseb + off); b0 = (f32x4){bflo(w.x), bfhi(w.x), bflo(w.y), bfhi(w.y)}; b1 = (f32x4){bflo(w.z), bfhi(w.z), bflo(w.w), bfhi(w.w)}; }
                    const f32x4 h0 = b0 + acc[ai][bj][m][0], h1 = b1 + acc[ai][bj][m][1];
                    ss += (h0[0] * h0[0] + h0[1] * h0[1]) + (h0[2] * h0[2] + h0[3] * h0[3]) + (h1[0] * h1[0] + h1[1] * h1[1]) + (h1[2] * h1[2] + h1[3] * h1[3]);
                    if (MODE == 1) { u32x4 w; w.x = pk2(h0[0], h0[1]); w.y = pk2(h0[2], h0[3]); w.z = pk2(h1[0], h1[1]); w.w = pk2(h1[2], h1[3]); *(u32x4*)(HB + off) = w; }
                    else { u32x4 w; w.x = pk2(h0[0], h0[1]); w.y = pk2(h0[2], h0[3]); w.z = pk2(h1[0], h1[1]); w.w = pk2(h1[2], h1[3]); *(u32x4*)(HB + off) = w; }
                }
                ss += __shfl_xor(ss, 16); ss += __shfl_xor(ss, 32);
                if (fq == 0) SS[(size_t)r * 16 + u.pn * 4 + wc] = ss;
            }
    }
};
struct EpiDownNorm {
    const bf16_t* baseb; float* OUT; const float* gfin; unsigned* xslot; unsigned* cnt; LAS unsigned char* ldsx;
    DI void operator()(Acc& acc, const Unit& u, int wr, int wc, int fr, int fq) const {
        const int lane = fr + 16 * fq, wid = wr * 4 + wc, tid = wid * 64 + lane;
        LAS float* P = (LAS float*)ldsx;
        LAS float* S = (LAS float*)(ldsx + 4096);
        const int rl0 = wr * 64 + fr;
#pragma unroll
        for (int ai = 0; ai < 2; ++ai)
#pragma unroll
            for (int m = 0; m < 4; ++m) {
                const int rl = rl0 + ai * 128 + m * 16; const int r = u.pm * 256 + rl; float ss = 0.f;
#pragma unroll
                for (int bj = 0; bj < 2; ++bj) {
                    const int c0 = u.pn * 256 + bj * 128 + wc * 32 + 8 * fq;
                    const u32x4 w = *(const u32x4*)(baseb + (size_t)r * DM + c0);
                    const f32x4 h0 = (f32x4){bflo(w.x), bfhi(w.x), bflo(w.y), bfhi(w.y)} + acc[ai][bj][m][0], h1 = (f32x4){bflo(w.z), bfhi(w.z), bflo(w.w), bfhi(w.w)} + acc[ai][bj][m][1];
                    acc[ai][bj][m][0] = h0; acc[ai][bj][m][1] = h1;
                    ss += (h0[0] * h0[0] + h0[1] * h0[1]) + (h0[2] * h0[2] + h0[3] * h0[3]) + (h1[0] * h1[0] + h1[1] * h1[1]) + (h1[2] * h1[2] + h1[3] * h1[3]);
                }
                ss += __shfl_xor(ss, 16); ss += __shfl_xor(ss, 32);
                if (fq == 0) P[rl * 4 + wc] = ss;
            }
        asm volatile("s_waitcnt lgkmcnt(0)" ::: "memory"); __builtin_amdgcn_s_barrier(); asm volatile("" ::: "memory");
        if (tid < 256) {
            const float s = (P[tid * 4 + 0] + P[tid * 4 + 1]) + (P[tid * 4 + 2] + P[tid * 4 + 3]);
            __hip_atomic_store(xslot + (size_t)(u.pm * 256 + tid) * 4 + u.pn, __builtin_bit_cast(unsigned, s), __ATOMIC_RELAXED, __HIP_MEMORY_SCOPE_AGENT);
        }
        asm volatile("s_waitcnt vmcnt(0)" ::: "memory");
        if (lane == 0) __hip_atomic_fetch_add(cnt + 64 * u.pm, 1u, __ATOMIC_RELAXED, __HIP_MEMORY_SCOPE_AGENT);
        if (wid == 0) {
            unsigned sp = 0;
            while ((unsigned)__builtin_amdgcn_readfirstlane(__hip_atomic_load(cnt + 64 * u.pm, __ATOMIC_RELAXED, __HIP_MEMORY_SCOPE_AGENT)) < 32u) { __builtin_amdgcn_s_sleep(2); if (++sp > (1u << 22)) break; }
        }
        asm volatile("s_waitcnt vmcnt(0) lgkmcnt(0)" ::: "memory"); __builtin_amdgcn_s_barrier(); asm volatile("" ::: "memory");
        if (tid < 256) {
            const unsigned* sl = xslot + (size_t)(u.pm * 256 + tid) * 4; float tot = 0.f;
#pragma unroll
            for (int t = 0; t < 4; ++t) tot += __builtin_bit_cast(float, __hip_atomic_load(sl + t, __ATOMIC_RELAXED, __HIP_MEMORY_SCOPE_AGENT));
            S[tid] = 1.0f / sqrtf(tot * (1.0f / DM) + EPS);
        }
        asm volatile("s_waitcnt vmcnt(0) lgkmcnt(0)" ::: "memory"); __builtin_amdgcn_s_barrier(); asm volatile("" ::: "memory");
#pragma unroll
        for (int bj = 0; bj < 2; ++bj) {
            const int c0 = u.pn * 256 + bj * 128 + wc * 32 + 8 * fq;
            const f32x4 g0 = *(const f32x4*)(gfin + c0), g1 = *(const f32x4*)(gfin + c0 + 4);
#pragma unroll
            for (int ai = 0; ai < 2; ++ai)
#pragma unroll
                for (int m = 0; m < 4; ++m) {
                    const int rl = rl0 + ai * 128 + m * 16; const float rr = S[rl]; float* o = OUT + (size_t)(u.pm * 256 + rl) * DM + c0;
                    *(f32x4*)o = acc[ai][bj][m][0] * rr * g0; *(f32x4*)(o + 4) = acc[ai][bj][m][1] * rr * g1;
                }
        }
    }
};
struct EpiGU {
    const float* SS; bf16_t* ACT;
    DI void operator()(const Acc& acc, const Unit& u, int wr, int wc, int fr, int fq) const {
        const int row0 = u.pm * 256 + wr * 64 + fr;
#pragma unroll
        for (int ai = 0; ai < 2; ++ai)
#pragma unroll
            for (int m = 0; m < 4; ++m) {
                const int r = row0 + ai * 128 + m * 16;
                const f32x4* sp = (const f32x4*)(SS + (size_t)r * 16);
                const f32x4 s0 = sp[0], s1 = sp[1], s2 = sp[2], s3 = sp[3];
                const float tot = ((s0[0] + s0[1]) + (s0[2] + s0[3])) + ((s1[0] + s1[1]) + (s1[2] + s1[3])) + ((s2[0] + s2[1]) + (s2[2] + s2[3])) + ((s3[0] + s3[1]) + (s3[2] + s3[3]));
                const float rr = 1.0f / sqrtf(tot * (1.0f / DM) + EPS);
#pragma unroll
                for (int bj = 0; bj < 2; ++bj) {
                    const int f0 = u.pn * 128 + bj * 64 + wc * 16 + 4 * fq;
                    const f32x4 g = acc[ai][bj][m][0] * rr, up = acc[ai][bj][m][1] * rr;
                    float o[4];
#pragma unroll
                    for (int i = 0; i < 4; ++i) o[i] = g[i] * sigmoidf_(g[i]) * up[i];
                    u32x2 w; w.x = pk2(o[0], o[1]); w.y = pk2(o[2], o[3]);
                    *(u32x2*)(ACT + (size_t)r * DFF + f0) = w;
                }
            }
    }
};


#ifndef EN_DSA
#define EN_DSA 1
#endif
#ifndef EN_WIN
#define EN_WIN 1
#endif
#ifndef EN_SLC
#define EN_SLC 1
#endif
#ifndef EN_CMP
#define EN_CMP 1
#endif
#define MFMA32(a, b, c) __builtin_amdgcn_mfma_f32_32x32x16_bf16((a), (b), (c), 0, 0, 0)
typedef short v4i16_t __attribute__((ext_vector_type(4)));
constexpr float SM_C = 0.125f * 1.4426950408889634f;
constexpr float NINF = -__builtin_inff();
DI int crow(int r, int h) { return (r & 3) + 8 * (r >> 2) + 4 * h; }
DI float fexp2(float x) { return __builtin_amdgcn_exp2f(x); }
DI s16x4 vtr(const LAS unsigned char* p) { return __builtin_bit_cast(s16x4, __builtin_amdgcn_ds_read_tr16_b64_v4i16((LAS v4i16_t*)p)); }
DI bf16x8 pack8(const f32x16& p, int s) {
    u32x4 w; w.x = pk2(p[8 * s], p[8 * s + 1]); w.y = pk2(p[8 * s + 2], p[8 * s + 3]); w.z = pk2(p[8 * s + 4], p[8 * s + 5]); w.w = pk2(p[8 * s + 6], p[8 * s + 7]);
    return __builtin_bit_cast(bf16x8, w);
}
DI f32x16 f16zero() { f32x16 z;
#pragma unroll
    for (int i = 0; i < 16; ++i) z[i] = 0.f;
    return z; }
struct FState { f32x16 o0, o1; float m, l; };
DI void fs_reset(FState& st) { st.o0 = f16zero(); st.o1 = f16zero(); st.m = NINF; st.l = 0.f; }
DI void flash_qk_bias(const LAS unsigned char* kb, const bf16x8 (&qf)[4], f32x16& p0, f32x16& p1, int r32, int h, const bf16x8& m0, const bf16x8& m1, const bf16x8& ef) {
    p0 = MFMA32(m0, ef, f16zero()); p1 = MFMA32(m1, ef, f16zero());
    const int sw = (r32 >> 1) & 7;
#pragma unroll
    for (int s = 0; s < 4; ++s) {
        const int off = r32 * 128 + (((2 * s + h) ^ sw) << 4);
        const bf16x8 a0 = *(const LAS bf16x8*)(kb + off), a1 = *(const LAS bf16x8*)(kb + off + 4096);
        p0 = MFMA32(a0, qf[s], p0); p1 = MFMA32(a1, qf[s], p1);
    }
}
DI void flash_qk(const LAS unsigned char* kb, const bf16x8 (&qf)[4], f32x16& p0, f32x16& p1, int r32, int h) {
    p0 = f16zero(); p1 = f16zero();
    const int sw = (r32 >> 1) & 7;
#pragma unroll
    for (int s = 0; s < 4; ++s) {
        const int off = r32 * 128 + (((2 * s + h) ^ sw) << 4);
        const bf16x8 a0 = *(const LAS bf16x8*)(kb + off), a1 = *(const LAS bf16x8*)(kb + off + 4096);
        p0 = MFMA32(a0, qf[s], p0); p1 = MFMA32(a1, qf[s], p1);
    }
}
DI unsigned cvtpk(float lo, float hi) { const f32x2 v = {lo, hi}; const bf16x2_t b = __builtin_convertvector(v, bf16x2_t); return __builtin_bit_cast(unsigned, b); }
DI bf16x8 pack8h(const f32x16& p, int s) {
    u32x4 w; w.x = cvtpk(p[8 * s], p[8 * s + 1]); w.y = cvtpk(p[8 * s + 2], p[8 * s + 3]); w.z = cvtpk(p[8 * s + 4], p[8 * s + 5]); w.w = cvtpk(p[8 * s + 6], p[8 * s + 7]);
    return __builtin_bit_cast(bf16x8, w);
}
DI float half_max(float v) { return fmaxf(v, __shfl_xor(v, 32)); }
DI float half_sum(float v) { return v + __shfl_xor(v, 32); }
constexpr float THR_RAW = 8.0f / SM_C;
DI void flash_pv(FState& st, f32x16& p0, f32x16& p1, bool rowon, const LAS unsigned char* vb, int lane) {
    float mx = fmaxf(p0[0], p1[0]);
#pragma unroll
    for (int r = 1; r < 16; ++r) asm("v_max3_f32 %0, %1, %2, %3" : "=v"(mx) : "v"(mx), "v"(p0[r]), "v"(p1[r]));
    mx = half_max(mx);
    mx = rowon ? mx : NINF;
    const bool upd = mx > st.m + THR_RAW;
    if (__any(upd)) {
        const float mn = upd ? mx : st.m;
        const float alpha = upd ? fexp2((st.m - mn) * SM_C) : 1.0f;
        st.m = mn; st.l *= alpha;
#pragma unroll
        for (int r = 0; r < 16; ++r) { st.o0[r] *= alpha; st.o1[r] *= alpha; }
    }
    const float cl = rowon ? SM_C : 0.0f;
    const float bl = rowon ? ((st.m == NINF) ? 0.0f : -st.m * SM_C) : NINF;
    float sum = 0.f;
#pragma unroll
    for (int r = 0; r < 16; ++r) { p0[r] = fexp2(__builtin_fmaf(p0[r], cl, bl)); p1[r] = fexp2(__builtin_fmaf(p1[r], cl, bl)); sum += p0[r] + p1[r]; }
    st.l += sum;
    const int h = lane >> 5;
    const int vx = (((lane & 15) >> 3) & 1) * 64;
    const LAS unsigned char* vp = vb + (4 * h + ((lane & 15) >> 2)) * 128 + ((lane >> 4) & 1) * 32 + (lane & 3) * 8;
#pragma unroll
    for (int sub = 0; sub < 2; ++sub)
#pragma unroll
        for (int s2 = 0; s2 < 2; ++s2) {
            const bf16x8 pf = pack8h(sub ? p1 : p0, s2);
            const LAS unsigned char* vq = vp + (32 * sub + 16 * s2) * 128;
            { const s16x4 lo = vtr(vq + vx), hi = vtr(vq + 1024 + vx); const bf16x8 vf = {lo[0], lo[1], lo[2], lo[3], hi[0], hi[1], hi[2], hi[3]}; st.o0 = MFMA32(vf, pf, st.o0); }
            { const s16x4 lo = vtr(vq + (64 - vx)), hi = vtr(vq + 1024 + (64 - vx)); const bf16x8 vf = {lo[0], lo[1], lo[2], lo[3], hi[0], hi[1], hi[2], hi[3]}; st.o1 = MFMA32(vf, pf, st.o1); }
        }
}
DI void flash_pv2(FState& sa, FState& sb, f32x16& a0, f32x16& a1, bool rona, f32x16& b0, f32x16& b1, bool ronb, const LAS unsigned char* va, const LAS unsigned char* vbb, int lane) {
    float mxa = fmaxf(a0[0], a1[0]), mxb = fmaxf(b0[0], b1[0]);
#pragma unroll
    for (int r = 1; r < 16; ++r) { asm("v_max3_f32 %0, %1, %2, %3" : "=v"(mxa) : "v"(mxa), "v"(a0[r]), "v"(a1[r])); asm("v_max3_f32 %0, %1, %2, %3" : "=v"(mxb) : "v"(mxb), "v"(b0[r]), "v"(b1[r])); }
    mxa = half_max(mxa); mxb = half_max(mxb);
    mxa = rona ? mxa : NINF; mxb = ronb ? mxb : NINF;
    const bool upa = mxa > sa.m + THR_RAW, upb = mxb > sb.m + THR_RAW;
    if (__any(upa || upb)) {
        const float mna = upa ? mxa : sa.m, mnb = upb ? mxb : sb.m;
        const float ala = upa ? fexp2((sa.m - mna) * SM_C) : 1.0f, alb = upb ? fexp2((sb.m - mnb) * SM_C) : 1.0f;
        sa.m = mna; sa.l *= ala; sb.m = mnb; sb.l *= alb;
#pragma unroll
        for (int r = 0; r < 16; ++r) { sa.o0[r] *= ala; sa.o1[r] *= ala; sb.o0[r] *= alb; sb.o1[r] *= alb; }
    }
    const float cla = rona ? SM_C : 0.0f, bla = rona ? ((sa.m == NINF) ? 0.0f : -sa.m * SM_C) : NINF;
    const float clb = ronb ? SM_C : 0.0f, blb = ronb ? ((sb.m == NINF) ? 0.0f : -sb.m * SM_C) : NINF;
    float suma = 0.f, sumb = 0.f;
#pragma unroll
    for (int r = 0; r < 16; ++r) {
        a0[r] = fexp2(__builtin_fmaf(a0[r], cla, bla)); b0[r] = fexp2(__builtin_fmaf(b0[r], clb, blb));
        a1[r] = fexp2(__builtin_fmaf(a1[r], cla, bla)); b1[r] = fexp2(__builtin_fmaf(b1[r], clb, blb));
        suma += a0[r] + a1[r]; sumb += b0[r] + b1[r];
    }
    sa.l += suma; sb.l += sumb;
    const int h = lane >> 5;
    const int vx = (((lane & 15) >> 3) & 1) * 64;
    const int voff = (4 * h + ((lane & 15) >> 2)) * 128 + ((lane >> 4) & 1) * 32 + (lane & 3) * 8;
#pragma unroll
    for (int sub = 0; sub < 2; ++sub)
#pragma unroll
        for (int s2 = 0; s2 < 2; ++s2) {
            const bf16x8 pfa = pack8h(sub ? a1 : a0, s2), pfb = pack8h(sub ? b1 : b0, s2);
            const LAS unsigned char* qa = va + voff + (32 * sub + 16 * s2) * 128; const LAS unsigned char* qb = vbb + voff + (32 * sub + 16 * s2) * 128;
            { const s16x4 lo = vtr(qa + vx), hi = vtr(qa + 1024 + vx); const bf16x8 vf = {lo[0], lo[1], lo[2], lo[3], hi[0], hi[1], hi[2], hi[3]}; sa.o0 = MFMA32(vf, pfa, sa.o0); }
            { const s16x4 lo = vtr(qb + vx), hi = vtr(qb + 1024 + vx); const bf16x8 vf = {lo[0], lo[1], lo[2], lo[3], hi[0], hi[1], hi[2], hi[3]}; sb.o0 = MFMA32(vf, pfb, sb.o0); }
            { const s16x4 lo = vtr(qa + (64 - vx)), hi = vtr(qa + 1024 + (64 - vx)); const bf16x8 vf = {lo[0], lo[1], lo[2], lo[3], hi[0], hi[1], hi[2], hi[3]}; sa.o1 = MFMA32(vf, pfa, sa.o1); }
            { const s16x4 lo = vtr(qb + (64 - vx)), hi = vtr(qb + 1024 + (64 - vx)); const bf16x8 vf = {lo[0], lo[1], lo[2], lo[3], hi[0], hi[1], hi[2], hi[3]}; sb.o1 = MFMA32(vf, pfb, sb.o1); }
        }
}
DI void fs_merge(FState& sa, const FState& sb) {
    const float m = fmaxf(sa.m, sb.m), mu = (m == NINF) ? 0.0f : m;
    const float fa = fexp2((sa.m - mu) * SM_C), fb = fexp2((sb.m - mu) * SM_C);
    sa.m = m; sa.l = sa.l * fa + sb.l * fb;
#pragma unroll
    for (int r = 0; r < 16; ++r) { sa.o0[r] = sa.o0[r] * fa + sb.o0[r] * fb; sa.o1[r] = sa.o1[r] * fa + sb.o1[r] * fb; }
}
DI void store_y(bf16_t* dst, const f32x16& y0, const f32x16& y1, int h) {
#pragma unroll
    for (int mm = 0; mm < 4; ++mm) {
        u32x2 w0; w0.x = pk2(y0[4 * mm], y0[4 * mm + 1]); w0.y = pk2(y0[4 * mm + 2], y0[4 * mm + 3]);
        u32x2 w1; w1.x = pk2(y1[4 * mm], y1[4 * mm + 1]); w1.y = pk2(y1[4 * mm + 2], y1[4 * mm + 3]);
        *(u32x2*)(dst + 8 * mm + 4 * h) = w0; *(u32x2*)(dst + 32 + 8 * mm + 4 * h) = w1;
    }
}

DI void nsa_task(LAS unsigned char* lds, const bf16_t* Z, const unsigned* selm, const bf16_t* OCMP, bf16_t* YA, int b, int hk, int c, int tid, int wave, int lane) {
    const int r32 = lane & 31, h = lane >> 5;
    const int tok = 64 * c + 8 * wave + (r32 >> 2), head = hk * 4 + (r32 & 3);
    const size_t grow = (size_t)b * SEQ + tok;
    const bf16_t* zr = Z + grow * NZ;
    bf16x8 qf[4];
#pragma unroll
    for (int s = 0; s < 4; ++s) qf[s] = *(const bf16x8*)(zr + ZC_QA + head * 64 + 16 * s + 8 * h);
    const unsigned selw = EN_SLC ? selm[grow * 2 + hk] : 0u;
    const float g_cmp = sigmoidf_(bf2f(zr[ZC_GA + head])), g_slc = sigmoidf_(bf2f(zr[ZC_GA + 8 + head])), g_win = sigmoidf_(bf2f(zr[ZC_GA + 16 + head]));
    f32x16 y0 = f16zero(), y1 = f16zero();
    FState st; fs_reset(st);
    const int nsel = EN_SLC ? c + 1 : 0, nwin = EN_WIN ? (c + 1 < 9 ? c + 1 : 9) : 0, ntot = nsel + nwin;
    const int skey = tid >> 3, sch = tid & 7;
    const int kdst = skey * 128 + ((sch ^ ((skey >> 1) & 7)) << 4), vdst = 8192 + skey * 128 + ((sch * 16) ^ (((skey >> 1) & 1) << 6));
    const bf16_t* sbase = Z + ((size_t)b * SEQ + skey) * NZ + hk * 64 + sch * 8;
    u32x4 kA = {0u, 0u, 0u, 0u}, vA = kA, kB = kA, vB = kA, kC = kA, vC = kA;
#define NSA_LOADT(it_, KR, VR) do { const int i_ = (it_); if (i_ < ntot) { const bool s_ = i_ < nsel; const int j_ = s_ ? i_ : c - (i_ - nsel); const bf16_t* p_ = sbase + (size_t)(64 * j_) * NZ; \
        KR = *(const u32x4*)(p_ + (s_ ? ZC_KS : ZC_KW)); VR = *(const u32x4*)(p_ + (s_ ? ZC_VS : ZC_VW)); } } while (0)
#define NSA_FINAL(gate_) do { const float lt_ = half_sum(st.l); const float inv_ = lt_ > 0.f ? (gate_) / lt_ : 0.f; \
        _Pragma("unroll") for (int r = 0; r < 16; ++r) { y0[r] += st.o0[r] * inv_; y1[r] += st.o1[r] * inv_; } fs_reset(st); } while (0)
#define NSA_STEP(it_, KR, VR) do { const int it = (it_); \
        LAS unsigned char* buf = lds + (it & 1) * 16384; \
        *(LAS u32x4*)(buf + kdst) = KR; *(LAS u32x4*)(buf + vdst) = VR; \
        __syncthreads(); \
        NSA_LOADT(it + 3, KR, VR); \
        if (it == nsel && nsel > 0) NSA_FINAL(g_slc); \
        const bool is_sel = it < nsel; const int j = is_sel ? it : c - (it - nsel); \
        f32x16 p0, p1; flash_qk(buf, qf, p0, p1, r32, h); \
        const int kb0 = 64 * j + 4 * h; \
        bool rowon = true; \
        if (is_sel) { \
            rowon = (selw >> j) & 1u; \
            if (j == c) { \
                _Pragma("unroll") for (int r = 0; r < 16; ++r) { const int kp = kb0 + (r & 3) + 8 * (r >> 2); p0[r] = (kp <= tok) ? p0[r] : NINF; p1[r] = (kp + 32 <= tok) ? p1[r] : NINF; } \
            } \
        } else if (j == c || j == c - 8) { \
            _Pragma("unroll") for (int r = 0; r < 16; ++r) { const int kp = kb0 + (r & 3) + 8 * (r >> 2); \
                p0[r] = (kp <= tok && kp > tok - 512) ? p0[r] : NINF; p1[r] = (kp + 32 <= tok && kp + 32 > tok - 512) ? p1[r] : NINF; } \
        } \
        flash_pv(st, p0, p1, rowon, buf + 8192, lane); } while (0)
    NSA_LOADT(0, kA, vA); NSA_LOADT(1, kB, vB); NSA_LOADT(2, kC, vC);
    for (int it0 = 0; it0 < ntot; it0 += 3) {
        NSA_STEP(it0, kA, vA);
        if (it0 + 1 < ntot) NSA_STEP(it0 + 1, kB, vB);
        if (it0 + 2 < ntot) NSA_STEP(it0 + 2, kC, vC);
    }
    if (nwin > 0) NSA_FINAL(g_win); else if (nsel > 0) NSA_FINAL(g_slc);
    if (EN_CMP) {
        const bf16_t* oc = OCMP + grow * 512 + head * 64;
#pragma unroll
        for (int mm = 0; mm < 4; ++mm) {
            const u32x2 w0 = *(const u32x2*)(oc + 8 * mm + 4 * h), w1 = *(const u32x2*)(oc + 32 + 8 * mm + 4 * h);
            y0[4 * mm] += g_cmp * bflo(w0.x); y0[4 * mm + 1] += g_cmp * bfhi(w0.x); y0[4 * mm + 2] += g_cmp * bflo(w0.y); y0[4 * mm + 3] += g_cmp * bfhi(w0.y);
            y1[4 * mm] += g_cmp * bflo(w1.x); y1[4 * mm + 1] += g_cmp * bfhi(w1.x); y1[4 * mm + 2] += g_cmp * bflo(w1.y); y1[4 * mm + 3] += g_cmp * bfhi(w1.y);
        }
    }
    store_y(YA + grow * 1024 + head * 64, y0, y1, h);
    __syncthreads();
#undef NSA_LOADT
#undef NSA_FINAL
#undef NSA_STEP
}

DI void dsa_task(LAS unsigned char* lds, const bf16_t* Z, const unsigned* dmask, bf16_t* YB, int b, int qi, int tid, int wave, int lane) {
    const int r32 = lane & 31, h = lane >> 5;
    const int tok = 32 * qi + 4 * wave + (r32 >> 3), head = r32 & 7;
    const size_t grow = (size_t)b * SEQ + tok;
    const bf16_t* zr = Z + grow * NZ;
    bf16x8 qf[4];
#pragma unroll
    for (int s = 0; s < 4; ++s) qf[s] = *(const bf16x8*)(zr + ZC_QB + head * 64 + 16 * s + 8 * h);
    const unsigned* dmw = dmask + ((size_t)b * SEQ + 32 * qi + 4 * wave) * 64;
    FState st, sb; fs_reset(st); fs_reset(sb);
    const int ntot = (qi >> 1) + 1, npair = (ntot + 1) >> 1;
    const int skey = tid >> 3, sch = tid & 7;
    const bf16_t* srow = Z + ((size_t)b * SEQ + skey) * NZ;
    const int kch = (sch ^ ((skey >> 1) & 7)) * 8, vch = (sch ^ (((skey >> 1) & 1) << 2)) * 8;
    const int wbase = wave * 1024;
#define DSA_DMA(p_) do { const int pp_ = (p_); if (pp_ < npair) { const int t0_ = 2 * pp_, t1_ = (2 * pp_ + 1 < ntot) ? 2 * pp_ + 1 : ntot - 1; LAS unsigned char* st_ = lds + (pp_ & 1) * 32768 + wbase; \
        const bf16_t* q0_ = srow + (size_t)(64 * t0_) * NZ; const bf16_t* q1_ = srow + (size_t)(64 * t1_) * NZ; \
        __builtin_amdgcn_global_load_lds((const unsigned*)(q0_ + ZC_KB + kch), (LAS unsigned*)(st_), 16, 0, 0); \
        __builtin_amdgcn_global_load_lds((const unsigned*)(q0_ + ZC_VB + vch), (LAS unsigned*)(st_ + 8192), 16, 0, 0); \
        __builtin_amdgcn_global_load_lds((const unsigned*)(q1_ + ZC_KB + kch), (LAS unsigned*)(st_ + 16384), 16, 0, 0); \
        __builtin_amdgcn_global_load_lds((const unsigned*)(q1_ + ZC_VB + vch), (LAS unsigned*)(st_ + 24576), 16, 0, 0); } } while (0)
#define DSA_MFRAG(dst, W0, W1, W2, W3) do { u32x4 m_ = {0u, 0u, 0u, 0u}; \
        if (h == 0) { m_.x = (__builtin_amdgcn_ubfe(~(W0), (unsigned)r32, 1u) | (__builtin_amdgcn_ubfe(~(W1), (unsigned)r32, 1u) << 16)) * 0xC700u; \
                      m_.y = (__builtin_amdgcn_ubfe(~(W2), (unsigned)r32, 1u) | (__builtin_amdgcn_ubfe(~(W3), (unsigned)r32, 1u) << 16)) * 0xC700u; } \
        dst = __builtin_bit_cast(bf16x8, m_); } while (0)
#define DSA_PAIR(p_) do { const int p = (p_); \
        LAS unsigned char* bufA = lds + (p & 1) * 32768; LAS unsigned char* bufB = bufA + 16384; \
        asm volatile("s_waitcnt vmcnt(0)" ::: "memory"); \
        __syncthreads(); \
        DSA_DMA(p + 1); \
        const u32x4 c0_ = wq0, c1_ = wq1, c2_ = wq2, c3_ = wq3; \
        if (p + 1 < npair) { wq0 = *(const u32x4*)(dmw + 4 * (p + 1)); wq1 = *(const u32x4*)(dmw + 64 + 4 * (p + 1)); wq2 = *(const u32x4*)(dmw + 128 + 4 * (p + 1)); wq3 = *(const u32x4*)(dmw + 192 + 4 * (p + 1)); } \
        bf16x8 efrag; { int lane_ = lane; asm volatile("" : "+v"(lane_)); const int tk = (lane_ & 31) >> 3; u32x4 e = {0u, 0u, 0u, 0u};   \
          if ((lane_ >> 5) == 0) { e.x = (tk == 0 ? 0x3F80u : 0u) | (tk == 1 ? 0x3F800000u : 0u); e.y = (tk == 2 ? 0x3F80u : 0u) | (tk == 3 ? 0x3F800000u : 0u); } \
          efrag = __builtin_bit_cast(bf16x8, e); } \
        bf16x8 ma0, ma1, mb0, mb1; DSA_MFRAG(ma0, c0_.x, c1_.x, c2_.x, c3_.x); DSA_MFRAG(ma1, c0_.y, c1_.y, c2_.y, c3_.y); DSA_MFRAG(mb0, c0_.z, c1_.z, c2_.z, c3_.z); DSA_MFRAG(mb1, c0_.w, c1_.w, c2_.w, c3_.w); \
        f32x16 pa0, pa1, pb0, pb1; flash_qk_bias(bufA, qf, pa0, pa1, r32, h, ma0, ma1, efrag); flash_qk_bias(bufB, qf, pb0, pb1, r32, h, mb0, mb1, efrag); \
        flash_pv2(st, sb, pa0, pa1, true, pb0, pb1, 2 * p + 1 < ntot, bufA + 8192, bufB + 8192, lane); } while (0)
    u32x4 wq0 = *(const u32x4*)(dmw), wq1 = *(const u32x4*)(dmw + 64), wq2 = *(const u32x4*)(dmw + 128), wq3 = *(const u32x4*)(dmw + 192);
    DSA_DMA(0);
    for (int p0_ = 0; p0_ < npair; ++p0_) DSA_PAIR(p0_);
#undef DSA_DMA
#undef DSA_MFRAG
#undef DSA_PAIR
    fs_merge(st, sb);
    const float lt = half_sum(st.l); const float inv = lt > 0.f ? 1.0f / lt : 0.f;
#pragma unroll
    for (int r = 0; r < 16; ++r) { st.o0[r] *= inv; st.o1[r] *= inv; }
    store_y(YB + grow * 1024 + 512 + head * 64, st.o0, st.o1, h);
    __syncthreads();
}


DI float gelu_tanh(float x) { const float u = 0.7978845608028654f * (x + 0.044715f * x * x * x); const float t = 1.0f - 2.0f / (__expf(2.0f * u) + 1.0f); return 0.5f * x * (1.0f + t); }
DI void compress_task(LAS unsigned char* lds, const bf16_t* Z, const bf16_t* W1t, const bf16_t* W2t, const float* bias1, bf16_t* KCC, bf16_t* VCT, int kv, int b, int hk, int nt4, int tid, int wave, int lane) {
    const int r32 = lane & 31, h = lane >> 5;
    const int n0 = 32 * nt4;
    const int srow = tid >> 3, sch = tid & 7;
    const bf16_t* asrc = W1t + (size_t)srow * 2048 + sch * 8;
    const int adst = srow * 128 + ((sch ^ ((srow >> 1) & 7)) << 4);
    const int nb = (n0 + srow > 126) ? 126 : n0 + srow;
    const bf16_t* bsrc = Z + ((size_t)b * SEQ + nb * 16) * NZ + (kv ? ZC_VC : ZC_KC) + hk * 64 + sch * 8;
    const bool bthr = tid < 256;
    const int aoff = (32 * wave + r32) * 128, boff = 32768 + r32 * 128, sw = (r32 >> 1) & 7;
    u32x4 a0[4], a1[4], b0v = {0u, 0u, 0u, 0u}, b1v = b0v;
#define CMP_LOAD(tk_, AR, BR) do { const int t_ = (tk_); if (t_ < 32) { _Pragma("unroll") for (int i = 0; i < 4; ++i) AR[i] = *(const u32x4*)(asrc + (size_t)i * 64 * 2048 + t_ * 64); \
        if (bthr) BR = *(const u32x4*)(bsrc + (size_t)t_ * NZ); } } while (0)
#define CMP_STEP(tk_, AR, BR, ST) do { LAS unsigned char* st_ = lds + (ST) * 36864; \
        _Pragma("unroll") for (int i = 0; i < 4; ++i) *(LAS u32x4*)(st_ + adst + i * 8192) = AR[i]; \
        if (bthr) *(LAS u32x4*)(st_ + 32768 + adst) = BR; \
        __syncthreads(); \
        CMP_LOAD((tk_) + 2, AR, BR); \
        _Pragma("unroll") for (int s = 0; s < 4; ++s) { const int co = ((2 * s + h) ^ sw) << 4; \
            const bf16x8 af = *(const LAS bf16x8*)(st_ + aoff + co); const bf16x8 bq = *(const LAS bf16x8*)(st_ + boff + co); acc = MFMA32(af, bq, acc); } } while (0)
    f32x16 acc = f16zero();
    CMP_LOAD(0, a0, b0v); CMP_LOAD(1, a1, b1v);
    for (int tk = 0; tk < 32; tk += 2) { CMP_STEP(tk, a0, b0v, 0); CMP_STEP(tk + 1, a1, b1v, 1); }
#undef CMP_LOAD
#undef CMP_STEP
    __syncthreads();
#pragma unroll
    for (int r = 0; r < 16; ++r) acc[r] = gelu_tanh(acc[r] + bias1[kv * 256 + 32 * wave + crow(r, h)]);
    f32x16 part0 = f16zero(), part1 = f16zero();
#pragma unroll
    for (int s2 = 0; s2 < 2; ++s2) {
        const bf16x8 pf = pack8(acc, s2);
#pragma unroll
        for (int dt = 0; dt < 2; ++dt) {
            const bf16_t* wp = W2t + (size_t)(32 * dt + r32) * 256 + 32 * wave + 16 * s2 + 4 * h;
            const u32x2 lo = *(const u32x2*)wp, hi = *(const u32x2*)(wp + 8);
            const u32x4 w4 = {lo.x, lo.y, hi.x, hi.y}; const bf16x8 wf = __builtin_bit_cast(bf16x8, w4);
            if (dt == 0) part0 = MFMA32(wf, pf, part0); else part1 = MFMA32(wf, pf, part1);
        }
    }
    LAS float* red = (LAS float*)lds;
#pragma unroll
    for (int r = 0; r < 16; ++r) { red[wave * 2048 + crow(r, h) * 32 + r32] = part0[r]; red[wave * 2048 + (32 + crow(r, h)) * 32 + r32] = part1[r]; }
    __syncthreads();
    const int nn = tid & 31, d4 = tid >> 5; float o[4];
#pragma unroll
    for (int e = 0; e < 4; ++e) { float s = 0.f;
#pragma unroll
        for (int w = 0; w < 8; ++w) s += red[w * 2048 + (4 * d4 + e) * 32 + nn];
        o[e] = s; }
    const int ng = n0 + nn;
    if (kv == 0) { u32x2 w; w.x = pk2(o[0], o[1]); w.y = pk2(o[2], o[3]); *(u32x2*)(KCC + ((size_t)(b * 2 + hk) * 128 + ng) * 64 + 4 * d4) = w; }
    else {
#pragma unroll
        for (int e = 0; e < 4; ++e) VCT[((size_t)(b * 2 + hk) * 64 + 4 * d4 + e) * 128 + ng] = (bf16_t)f2bf(o[e]);
    }
    __syncthreads();
}

DI void cmp_task(const bf16_t* Z, const bf16_t* KCC, const bf16_t* VCT, bf16_t* OCMP, unsigned* selm, int b, int hk, int tg, int lane) {
    const int r32 = lane & 31, h = lane >> 5;
    const int tok = 8 * tg + (r32 >> 2), g = r32 & 3, head = hk * 4 + g;
    const size_t grow = (size_t)b * SEQ + tok;
    const bf16_t* zr = Z + grow * NZ;
    bf16x8 qf[4];
#pragma unroll
    for (int s = 0; s < 4; ++s) qf[s] = *(const bf16x8*)(zr + ZC_QA + head * 64 + 16 * s + 8 * h);
    const bf16_t* kc = KCC + (size_t)(b * 2 + hk) * 128 * 64; const bf16_t* vt = VCT + (size_t)(b * 2 + hk) * 64 * 128;
    const int tmax = 8 * tg + 7;
    const int nsub = tmax < 31 ? 0 : (((tmax - 31) >> 4) >> 5) + 1;
    f32x16 p[4];
#pragma unroll
    for (int sub = 0; sub < 4; ++sub) {
        if (sub < nsub) {
            p[sub] = f16zero();
#pragma unroll
            for (int s = 0; s < 4; ++s) { const bf16x8 af = *(const bf16x8*)(kc + (size_t)(32 * sub + r32) * 64 + 16 * s + 8 * h); p[sub] = MFMA32(af, qf[s], p[sub]); }
#pragma unroll
            for (int r = 0; r < 16; ++r) { const int n = 32 * sub + crow(r, h); p[sub][r] = (16 * n + 31 <= tok) ? p[sub][r] * SM_C : NINF; }
        } else {
#pragma unroll
            for (int r = 0; r < 16; ++r) p[sub][r] = NINF;
        }
    }
    float mx = NINF;
#pragma unroll
    for (int sub = 0; sub < 4; ++sub)
#pragma unroll
        for (int r = 0; r < 16; ++r) mx = fmaxf(mx, p[sub][r]);
    mx = fmaxf(mx, __shfl_xor(mx, 32));
    const float mu = (mx == NINF) ? 0.f : mx;
    float sum = 0.f;
#pragma unroll
    for (int sub = 0; sub < 4; ++sub)
#pragma unroll
        for (int r = 0; r < 16; ++r) { p[sub][r] = fexp2(p[sub][r] - mu); sum += p[sub][r]; }
    const float lt = sum + __shfl_xor(sum, 32); const float inv = lt > 0.f ? 1.0f / lt : 0.f;
#pragma unroll
    for (int sub = 0; sub < 4; ++sub)
#pragma unroll
        for (int r = 0; r < 16; ++r) p[sub][r] *= inv;
    f32x16 o0 = f16zero(), o1 = f16zero();
#pragma unroll
    for (int sub = 0; sub < 4; ++sub) if (sub < nsub) {
#pragma unroll
        for (int s2 = 0; s2 < 2; ++s2) {
            const bf16x8 pf = pack8(p[sub], s2);
#pragma unroll
            for (int dt = 0; dt < 2; ++dt) {
                const bf16_t* wp = vt + (size_t)(32 * dt + r32) * 128 + 32 * sub + 16 * s2 + 4 * h;
                const u32x2 lo = *(const u32x2*)wp, hi = *(const u32x2*)(wp + 8);
                const u32x4 w4 = {lo.x, lo.y, hi.x, hi.y}; const bf16x8 vf = __builtin_bit_cast(bf16x8, w4);
                if (dt == 0) o0 = MFMA32(vf, pf, o0); else o1 = MFMA32(vf, pf, o1);
            }
        }
    }
    store_y(OCMP + grow * 512 + head * 64, o0, o1, h);
    const int cur = tg >> 3; unsigned mask;
    if (cur <= 7) mask = (2u << cur) - 1u;
    else {
        float a[4][4], PL[4][4];
#pragma unroll
        for (int T = 0; T < 4; ++T)
#pragma unroll
            for (int mm = 0; mm < 4; ++mm) { a[T][mm] = (p[T][4 * mm] + p[T][4 * mm + 1]) + (p[T][4 * mm + 2] + p[T][4 * mm + 3]); PL[T][mm] = __shfl_xor(p[T][4 * mm + 3], 32); }
#pragma unroll
        for (int T = 0; T < 4; ++T)
#pragma unroll
            for (int mm = 0; mm < 4; ++mm) { const float prev = mm > 0 ? PL[T][mm - 1] : (T > 0 ? PL[T - 1][3] : 0.f); a[T][mm] += h ? PL[T][mm] : prev; }
        float ev[4][4], od[4][4], mine[4];
#pragma unroll
        for (int T = 0; T < 4; ++T)
#pragma unroll
            for (int mm = 0; mm < 4; ++mm) {
                float v = a[T][mm]; v += __shfl_xor(v, 1); v += __shfl_xor(v, 2);
                const int j = 8 * T + 2 * mm + h; v = (j >= 1 && j <= cur - 2) ? v : -1.0f;
                const float vx = __shfl_xor(v, 32);
                ev[T][mm] = h ? vx : v; od[T][mm] = h ? v : vx; a[T][mm] = v;
            }
#pragma unroll
        for (int mm = 0; mm < 4; ++mm) mine[mm] = g == 0 ? a[0][mm] : g == 1 ? a[1][mm] : g == 2 ? a[2][mm] : a[3][mm];
        unsigned word = 0u;
#pragma unroll
        for (int mm = 0; mm < 4; ++mm) {
            const int jm = 8 * g + 2 * mm + h; const float v = mine[mm]; int rank = 0;
#pragma unroll
            for (int T = 0; T < 4; ++T)
#pragma unroll
                for (int m2 = 0; m2 < 4; ++m2) { const int je = 8 * T + 2 * m2;
                    rank += (ev[T][m2] > v || (ev[T][m2] == v && je < jm)) ? 1 : 0; rank += (od[T][m2] > v || (od[T][m2] == v && je + 1 < jm)) ? 1 : 0; }
            if (v >= 0.f && rank < 5) word |= 1u << jm;
        }
        word |= __shfl_xor(word, 1); word |= __shfl_xor(word, 2); word |= __shfl_xor(word, 32);
        mask = word | 1u | (1u << cur) | (1u << (cur - 1));
    }
    if (g == 0 && h == 0) selm[grow * 2 + hk] = mask;
}

constexpr size_t SC_PB = (size_t)64 * 64 * (32 * 33 / 2);
DI size_t sc_rowoff(int b, int t) { const int c = t >> 6; return (size_t)b * SC_PB + (size_t)4096 * (c * (c + 1) / 2) + (size_t)(t & 63) * (64 * (c + 1)); }
DI void score_range(const bf16_t* Z, float* SC, int i0, int i1, int lane) {
    const int r32 = lane & 31, h = lane >> 5;
    if (i0 >= i1) return;
    int b = i0 / 2080; const int rem = i0 - b * 2080;
    int qt = (int)((sqrtf(8.0f * (float)rem + 1.0f) - 1.0f) * 0.5f);
    while (qt * (qt + 1) / 2 > rem) --qt;
    while ((qt + 1) * (qt + 2) / 2 <= rem) ++qt;
    int sub = rem - qt * (qt + 1) / 2;
    bf16x8 qf[4][4]; float iwr[4][16]; float* sbase = nullptr; int Lrow = 0;
    bf16x8 kf[4], kn[4];
#define SCORE_LOADQ() do { const bf16_t* zq_ = Z + ((size_t)b * SEQ + 32 * qt) * NZ; \
        _Pragma("unroll") for (int hh = 0; hh < 4; ++hh) \
            _Pragma("unroll") for (int s = 0; s < 4; ++s) qf[hh][s] = *(const bf16x8*)(zq_ + (size_t)r32 * NZ + ZC_IQ + hh * 64 + 16 * s + 8 * h); \
        _Pragma("unroll") for (int r = 0; r < 16; ++r) { const u32x2 w_ = *(const u32x2*)(zq_ + (size_t)crow(r, h) * NZ + ZC_IW); \
            iwr[0][r] = bflo(w_.x) * 0.0625f; iwr[1][r] = bfhi(w_.x) * 0.0625f; iwr[2][r] = bflo(w_.y) * 0.0625f; iwr[3][r] = bfhi(w_.y) * 0.0625f; } \
        { const int c_ = qt >> 1; Lrow = 64 * (c_ + 1); sbase = SC + (size_t)b * SC_PB + (size_t)4096 * (c_ * (c_ + 1) / 2) + (size_t)((qt & 1) * 32 + 4 * h) * Lrow + r32; } } while (0)
#define SCORE_LOADK(dst, b_, sub_) do { const bf16_t* kr_ = Z + ((size_t)(b_) * SEQ + 32 * (sub_) + r32) * NZ + ZC_IK + 8 * h; \
        _Pragma("unroll") for (int s = 0; s < 4; ++s) dst[s] = *(const bf16x8*)(kr_ + 16 * s); } while (0)
    SCORE_LOADQ();
    SCORE_LOADK(kf, b, sub);
    for (int i = i0; i < i1; ++i) {
        int nb = b, nq = qt, ns = sub + 1;
        if (ns > nq) { ns = 0; ++nq; if (nq == 64) { nq = 0; ++nb; } }
        const bool more = i + 1 < i1;
        if (more) SCORE_LOADK(kn, nb, ns);
        f32x16 sc = f16zero();
#pragma unroll
        for (int hh = 0; hh < 4; ++hh) {
            f32x16 acc = f16zero();
#pragma unroll
            for (int s = 0; s < 4; ++s) acc = MFMA32(qf[hh][s], kf[s], acc);
#pragma unroll
            for (int r = 0; r < 16; ++r) sc[r] += iwr[hh][r] * fmaxf(acc[r], 0.f);
        }
#pragma unroll
        for (int r = 0; r < 16; ++r) sbase[(size_t)((r & 3) + 8 * (r >> 2)) * Lrow + 32 * sub] = sc[r];
        if (more) {
            const bool newq = (nq != qt) || (nb != b);
            b = nb; qt = nq; sub = ns;
            if (newq) SCORE_LOADQ();
#pragma unroll
            for (int s = 0; s < 4; ++s) kf[s] = kn[s];
        }
    }
#undef SCORE_LOADQ
#undef SCORE_LOADK
}

DI void select_row(const float* SC, unsigned* dmask, int b, int t, int lane) {
    unsigned* dm = dmask + ((size_t)b * SEQ + t) * 64;
    const int nvalid = t + 1;
    if (nvalid <= 256) {
        const int w = lane;
        const int lo = 32 * w; unsigned bits = 0u;
        if (lo + 31 <= t) bits = 0xffffffffu; else if (lo <= t) bits = (2u << (t - lo)) - 1u;
        dm[w] = bits; return;
    }
    const int nch = (nvalid + 255) >> 8;
    const float* srow = SC + sc_rowoff(b, t) + 4 * lane;
    unsigned u[8][4];
#pragma unroll
    for (int k = 0; k < 8; ++k) {
        if (k < nch) {
            const f32x4 v = *(const f32x4*)(srow + 256 * k);
#pragma unroll
            for (int e = 0; e < 4; ++e) { const unsigned bits = __builtin_bit_cast(unsigned, v[e] + 0.0f); const unsigned key = ((int)bits < 0) ? ~bits : (bits | 0x80000000u);
                u[k][e] = (256 * k + 4 * lane + e <= t) ? key : 0u; }
        } else { u[k][0] = 0u; u[k][1] = 0u; u[k][2] = 0u; u[k][3] = 0u; }
    }
#define SEL_COUNT(cand_, cnt_) do { unsigned cl_ = 0u; const unsigned cs_ = (cand_); \
        _Pragma("unroll") for (int k2 = 0; k2 < 4; ++k2) if (2 * k2 < nch) { \
            _Pragma("unroll") for (int q = 0; q < 8; ++q) asm("v_cmp_le_u32_e32 vcc, %2, %1\n\tv_addc_co_u32_e32 %0, vcc, 0, %0, vcc" : "+v"(cl_) : "v"(u[2 * k2 + (q >> 2)][q & 3]), "s"(cs_) : "vcc"); } \
        int v_ = (int)cl_;        \
        v_ += __builtin_amdgcn_update_dpp(0, v_, 0x111, 0xf, 0xf, false); \
        v_ += __builtin_amdgcn_update_dpp(0, v_, 0x112, 0xf, 0xf, false); \
        v_ += __builtin_amdgcn_update_dpp(0, v_, 0x114, 0xf, 0xf, false); \
        v_ += __builtin_amdgcn_update_dpp(0, v_, 0x118, 0xf, 0xf, false); \
        v_ += __builtin_amdgcn_update_dpp(0, v_, 0x142, 0xa, 0xf, false); \
        v_ += __builtin_amdgcn_update_dpp(0, v_, 0x143, 0xc, 0xf, false); \
        cnt_ = __builtin_amdgcn_readlane(v_, 63); } while (0)
    unsigned T = 0u; bool hit = false; int startbit = 31;
    {
        int cnt; SEL_COUNT(0xC0000000u, cnt);
        if (cnt < 256) {
#pragma unroll 1
            for (unsigned e = 0x7Fu; e >= 0x7Bu; --e) {
                const unsigned cand = 0x80000000u | (e << 23); SEL_COUNT(cand, cnt);
                if (cnt >= 256) { T = cand; startbit = 22; hit = (cnt == 256); break; }
            }
        }
    }
    if (!hit) {
        for (int bit = startbit; bit >= 0; --bit) {
            const unsigned cand = T | (1u << bit); int cnt; SEL_COUNT(cand, cnt);
            if (cnt >= 256) { T = cand; if (cnt == 256) { hit = true; break; } }
        }
    }
#undef SEL_COUNT
    int cgt = 0, cge = 256;
    if (!hit) { cge = 0;
#pragma unroll
    for (int k = 0; k < 8; ++k) if (k < nch) {
#pragma unroll
        for (int e = 0; e < 4; ++e) { cgt += __popcll(__ballot(u[k][e] > T)); cge += __popcll(__ballot(u[k][e] >= T)); }
    }
    }
    const int need = 256 - cgt;
    const bool exact = (cge == 256);
    int tie_before = 0;
    const unsigned long long ltmask = (1ull << lane) - 1ull;
#pragma unroll
    for (int k = 0; k < 8; ++k) {
        unsigned nib = 0u;
        if (k < nch) {
            if (exact) {
#pragma unroll
                for (int e = 0; e < 4; ++e) nib |= (u[k][e] >= T ? 1u : 0u) << e;
            } else {
                unsigned long long bm[4]; int lanes_before = 0, tot = 0;
#pragma unroll
                for (int e = 0; e < 4; ++e) { bm[e] = __ballot(u[k][e] == T); lanes_before += __popcll(bm[e] & ltmask); tot += __popcll(bm[e]); }
                int rank = tie_before + lanes_before;
#pragma unroll
                for (int e = 0; e < 4; ++e) { const bool eq = (u[k][e] == T); const bool s = (u[k][e] > T) || (eq && rank < need); nib |= (s ? 1u : 0u) << e; rank += eq ? 1 : 0; }
                tie_before += tot;
            }
        }
        unsigned val = nib << (4 * (lane & 7));
        val |= __shfl_xor(val, 1); val |= __shfl_xor(val, 2); val |= __shfl_xor(val, 4);
        if ((lane & 7) == 0) dm[8 * k + (lane >> 3)] = val;
    }
}

struct MapIdent { DI int operator()(int d, int& sel) const { sel = 0; return d; } };
struct MapInProj {
    DI int operator()(int c, int& sel) const {
        sel = 0;
        if (c < 1792) {
            const int hb = c >> 6, g = c & 63, w = g >> 5, fq = (g >> 3) & 3, n = (g >> 2) & 1, i = g & 3, d = 32 * n + 16 * w + 4 * fq + i;
            int base;
            if (hb < 8) base = 0 + 64 * hb; else if (hb < 10) base = 512 + 64 * (hb - 8); else if (hb < 12) base = 768 + 64 * (hb - 10); else if (hb < 14) base = 1024 + 64 * (hb - 12);
            else if (hb < 22) base = 1304 + 64 * (hb - 14); else if (hb < 23) base = 1816; else if (hb < 27) base = 1944 + 64 * (hb - 23); else base = 2200;
            return base + d;
        }
        if (c < 1920) return 640 + (c - 1792);
        if (c < 2048) return 896 + (c - 1920);
        if (c < 2176) return 1152 + (c - 2048);
        if (c < 2240) return 1880 + (c - 2176);
        if (c < 2264) return 1280 + (c - 2240);
        if (c < 2268) return 2264 + (c - 2264);
        if (c < 2304) return -1;
        return 2268 + (c - 2304);
    }
};
struct MapGU {
    DI int operator()(int c, int& sel) const {
        sel = (c >> 2) & 1;
        return 128 * (c >> 8) + 64 * ((c >> 7) & 1) + 16 * ((c >> 5) & 3) + 4 * ((c >> 3) & 3) + (c & 3);
    }
};
template <class Map>
DI void transpose_item(const float* W0, const float* W1, int N, int K, int Nd, const float* kscale, bf16_t* WT, Map map, LAS float* scr, int it, int lane, int ldk = 0, int koff = 0) {
    if (ldk == 0) ldk = K;
    const int nblk = Nd / 32;
    const int kb = it / nblk, db = it % nblk, k0 = 64 * kb, d0 = 32 * db;
    int sel; const int col = map(d0 + (lane & 31), sel);
    const float* W = sel ? W1 : W0;
    float v[32];
#pragma unroll
    for (int i = 0; i < 32; ++i) { const int kk = 2 * i + (lane >> 5); v[i] = (col >= 0) ? W[(size_t)(k0 + kk) * N + col] : 0.f; }
    if (kscale) {
#pragma unroll
        for (int i = 0; i < 32; ++i) v[i] *= kscale[k0 + 2 * i + (lane >> 5)];
    }
#pragma unroll
    for (int i = 0; i < 32; ++i) scr[(2 * i + (lane >> 5)) * 33 + (lane & 31)] = v[i];
    asm volatile("s_waitcnt lgkmcnt(0)" ::: "memory");
    const int c = lane & 7;
#pragma unroll
    for (int j = 0; j < 4; ++j) { const int n = (lane >> 3) + 8 * j; const LAS float* s = scr + (8 * c) * 33 + n;
        u32x4 o; o.x = pk2(s[0 * 33], s[1 * 33]); o.y = pk2(s[2 * 33], s[3 * 33]); o.z = pk2(s[4 * 33], s[5 * 33]); o.w = pk2(s[6 * 33], s[7 * 33]);
        *(u32x4*)(WT + (size_t)(d0 + n) * ldk + koff + k0 + 8 * c) = o; }
    asm volatile("s_waitcnt lgkmcnt(0)" ::: "memory");
}

struct Args { const float* in[17]; float* out; unsigned char* ws; };

__global__ void __launch_bounds__(NTHR, 2) fwd_kernel(Args a) {
    extern __shared__ __attribute__((aligned(16))) unsigned char lds_raw[];
    LAS unsigned char* lds = (LAS unsigned char*)lds_raw;
    const int tid = threadIdx.x, lane = tid & 63, wave = __builtin_amdgcn_readfirstlane(tid >> 6);
    const int G = gridDim.x, gw = blockIdx.x * NWAVES + wave, NGW = G * NWAVES;
    volatile LAS unsigned* lctl = (volatile LAS unsigned*)(lds + 131072);
    if (tid < 4) lctl[tid] = 0u;
    __syncthreads();
    XcdBarrier xbar = xcd_barrier_post((unsigned*)(a.ws + WS_CTL), lctl);
    unsigned char* ws = a.ws;
    const float* x = a.in[0];
    bf16_t* Win_t = (bf16_t*)(ws + WS_WIN); bf16_t* W1k_t = (bf16_t*)(ws + WS_W1K); bf16_t* W1v_t = (bf16_t*)(ws + WS_W1V);
    bf16_t* W2k_t = (bf16_t*)(ws + WS_W2K); bf16_t* W2v_t = (bf16_t*)(ws + WS_W2V); float* bias1 = (float*)(ws + WS_BIAS1);
    float* ropec = (float*)(ws + WS_ROPE); float* ropes = ropec + SEQ * 32;
    bf16_t* Wba_t = (bf16_t*)(ws + WS_WBA); bf16_t* Wbb_t = (bf16_t*)(ws + WS_WBB); bf16_t* Wo_t = (bf16_t*)(ws + WS_WO);
    bf16_t* Wgu_t = (bf16_t*)(ws + WS_WGU); bf16_t* Wd_t = (bf16_t*)(ws + WS_WD);
    bf16_t* XN = (bf16_t*)(ws + WS_XN); bf16_t* Z = (bf16_t*)(ws + WS_Z); bf16_t* ACT = (bf16_t*)(ws + WS_ACT);
    bf16_t* T1 = (bf16_t*)(ws + WS_T1); bf16_t* MG = (bf16_t*)(ws + WS_MG); bf16_t* HB = (bf16_t*)(ws + WS_HB);
    float* SS1 = (float*)(ws + WS_SS1); float* SS2 = (float*)(ws + WS_SS2);
    unsigned char* os = (unsigned char*)a.out;
    bf16_t* YA = (bf16_t*)(os + OS_YA); bf16_t* YB = YA;
    bf16_t* OCMP = (bf16_t*)(os + OS_OCMP); unsigned* DMASK = (unsigned*)(os + OS_DMASK); unsigned* SELM = (unsigned*)(os + OS_SELM);
    float* SC = (float*)(ws + WS_SC); bf16_t* KCC = (bf16_t*)(ws + WS_KCC); bf16_t* VCT = (bf16_t*)(ws + WS_VCT);
    unsigned* TASKTAB = (unsigned*)(ws + WS_BIAS1 + 4096);
    float* BPART = (float*)(ws + WS_BIAS1 + 16384);

#ifndef REP_P0
#define REP_P0 1
#endif
#ifndef REP_P1
#define REP_P1 1
#endif
#ifndef REP_P7
#define REP_P7 1
#endif
    for (int rep = 0; rep < REP_P0; ++rep) {
        LAS float* scr = (LAS float*)(lds + wave * 16384);
        {
            constexpr int I0 = (DM / 64) * (NZ / 32), I1 = 32 * 8, I3 = 4 * 2;
            constexpr int NIT = I0 + 2 * I1 + 2 * I3;
            for (int it0 = gw; it0 < NIT; it0 += NGW) {
                int r = it0;
                if (r < I0) { transpose_item(a.in[2], a.in[2], DIN, DM, NZ, nullptr, Win_t, MapInProj(), scr, r, lane); continue; } r -= I0;
                if (r < I1) { transpose_item(a.in[4], a.in[4], 256, 2048, 256, nullptr, W1k_t, MapIdent(), scr, r, lane); continue; } r -= I1;
                if (r < I1) { transpose_item(a.in[7], a.in[7], 256, 2048, 256, nullptr, W1v_t, MapIdent(), scr, r, lane); continue; } r -= I1;
                if (r < I3) { transpose_item(a.in[5], a.in[5], 64, 256, 64, nullptr, W2k_t, MapIdent(), scr, r, lane); continue; } r -= I3;
                transpose_item(a.in[8], a.in[8], 64, 256, 64, nullptr, W2v_t, MapIdent(), scr, r, lane);
            }
        }
        const float* gmix = a.in[1];
        for (int m = gw; m < MTOK; m += 4 * NGW) {
            f32x4 v[4][4]; float s[4];
#pragma unroll
            for (int q = 0; q < 4; ++q) { const int mq = (m + q * NGW < MTOK) ? m + q * NGW : m; const f32x4* xr = (const f32x4*)(x + (size_t)mq * DM) + lane;
#pragma unroll
                for (int j = 0; j < 4; ++j) v[q][j] = xr[64 * j]; }
#pragma unroll
            for (int q = 0; q < 4; ++q) { s[q] = 0.f;
#pragma unroll
                for (int j = 0; j < 4; ++j) s[q] += (v[q][j][0] * v[q][j][0] + v[q][j][1] * v[q][j][1]) + (v[q][j][2] * v[q][j][2] + v[q][j][3] * v[q][j][3]); }
#pragma unroll
            for (int o = 1; o < 64; o <<= 1) {
#pragma unroll
                for (int q = 0; q < 4; ++q) s[q] += __shfl_xor(s[q], o); }
            const f32x4* gr = (const f32x4*)gmix + lane;
#pragma unroll
            for (int q = 0; q < 4; ++q) if (m + q * NGW < MTOK) {
                const float rr = 1.0f / sqrtf(s[q] * (1.0f / DM) + EPS);
                u32x2* o8 = (u32x2*)(XN + (size_t)(m + q * NGW) * DM) + lane;
#pragma unroll
                for (int j = 0; j < 4; ++j) { const f32x4 g = gr[64 * j]; u32x2 w; w.x = pk2(v[q][j][0] * rr * g[0], v[q][j][1] * rr * g[1]); w.y = pk2(v[q][j][2] * rr * g[2], v[q][j][3] * rr * g[3]); o8[64 * j] = w; }
            }
        }
        for (int i = blockIdx.x * NTHR + tid; i < SEQ * 32; i += G * NTHR) {
            const int pos = i >> 5, j = i & 31; const float inv = powf(10000.0f, -(float)j / 32.0f); const float ang = (float)pos * inv;
            ropec[i] = cosf(ang); ropes[i] = sinf(ang);
        }
        for (int o = NGW - 1 - gw; o < 256; o += NGW) {
            const int kv = o >> 7, jb = (o >> 5) & 3, kc = o & 31; const float* pos = a.in[kv ? 6 : 3]; const float* w1 = a.in[kv ? 7 : 4]; float s = 0.f;
#pragma unroll 8
            for (int k = 0; k < 64; ++k) s += pos[kc * 64 + k] * w1[(size_t)(kc * 64 + k) * 256 + jb * 64 + lane];
            BPART[kc * 512 + kv * 256 + jb * 64 + lane] = s;
        }
        if (gw == NGW - 1 - 256 || (NGW <= 256 && gw == 0)) {
            for (int k = lane; k < 96; k += 64) {
                const int cost = k < 32 ? 7 * ((k + 1) + (k + 1 < 9 ? k + 1 : 9)) : 6 * (((k - 32) >> 1) + 1), cnt = k < 32 ? 32 : 16; int pos = 0;
                for (int k2 = 0; k2 < 96; ++k2) { const int c2 = k2 < 32 ? 7 * ((k2 + 1) + (k2 + 1 < 9 ? k2 + 1 : 9)) : 6 * (((k2 - 32) >> 1) + 1), n2 = k2 < 32 ? 32 : 16;
                    if (c2 > cost || (c2 == cost && k2 < k)) pos += n2; }
                for (int bb = 0; bb < cnt; ++bb) TASKTAB[pos + bb] = (unsigned)k | ((unsigned)bb << 8);
            }
        }
    }
    xcd_barrier(xbar);
    if (blockIdx.x == 0) { float s = 0.f; for (int kc = 0; kc < 32; ++kc) s += BPART[kc * 512 + tid]; bias1[tid] = s; }
    for (int rep = 0; rep < REP_P1; ++rep) { pg8::Gemm g{XN, Win_t, MTOK, NZ, DM}; pg8::StaticOrder S; S.init(MTOK, NZ, G, (int)blockIdx.x); EpiInProj E{Z, ropec, ropes}; pg8::gemm_phase(lds, g, S, E); }
    {
        const int nunits = (MTOK / 256) * (NZ / 256), rem = nunits % G;
        const int nhelp = rem ? G - rem : G, hid = rem ? (int)blockIdx.x - rem : (int)blockIdx.x;
        if (hid >= 0) {
            LAS float* scr = (LAS float*)(lds + wave * 16384);
            constexpr int I5 = 8 * 32, I7 = 16 * 32, I8 = 16 * (NGU / 32), I9 = (DFF / 64) * 32;
            constexpr int NIT2 = 2 * I5 + I7 + I8 + I9;
            for (int it0 = hid * NWAVES + wave; it0 < NIT2; it0 += nhelp * NWAVES) {
                int r = it0;
                if (r < I8) { transpose_item(a.in[13], a.in[14], DFF, DM, NGU, a.in[12], Wgu_t, MapGU(), scr, r, lane); continue; } r -= I8;
                if (r < I9) { transpose_item(a.in[15], a.in[15], DM, DFF, DM, nullptr, Wd_t, MapIdent(), scr, r, lane); continue; } r -= I9;
                if (r < I7) { transpose_item(a.in[11], a.in[11], DM, DM, DM, nullptr, Wo_t, MapIdent(), scr, r, lane); continue; } r -= I7;
                if (r < I5) { transpose_item(a.in[9], a.in[9], DM, 512, DM, nullptr, Wba_t, MapIdent(), scr, r, lane, 1024, 0); continue; } r -= I5;
                transpose_item(a.in[10], a.in[10], DM, 512, DM, nullptr, Wba_t, MapIdent(), scr, r, lane, 1024, 512);
            }
        }
    }
    xcd_barrier(xbar);
#ifndef REP_P2
#define REP_P2 1
#endif
#define REP_P2A 1
#define REP_P2B 1
#define REP_P3A 1
#define REP_P3B 1
#ifndef REP_P3
#define REP_P3 1
#endif
    for (int rep = 0; rep < REP_P2; ++rep) {
    for (int rp = 0; rp < REP_P2A; ++rp)
    if (EN_SLC || EN_CMP) for (int task = blockIdx.x; task < 256; task += G) { const int kv = task >> 7;
        compress_task(lds, Z, kv ? W1v_t : W1k_t, kv ? W2v_t : W2k_t, bias1, KCC, VCT, kv, (task >> 3) & 15, (task >> 2) & 1, task & 3, tid, wave, lane); }
    for (int rp = 0; rp < REP_P2B; ++rp)
    if (EN_DSA) { const int per = (33280 + NGW - 1) / NGW; const int i0 = gw * per, i1 = (i0 + per < 33280) ? i0 + per : 33280; score_range(Z, SC, i0, i1, lane); }
    }
    xcd_barrier(xbar);
    {
        const int nrow = (MTOK - gw + NGW - 1) / NGW, ncmp = (8192 - gw + NGW - 1) / NGW;
        const int stride = nrow > 0 && ncmp > 0 ? (nrow / ncmp > 0 ? nrow / ncmp : 1) : 1, phase = ((wave >> 2) * (stride >> 1) + (wave & 1)) % stride;
        int ci = 0;
        for (int i = 0; i < nrow || ci < ncmp; ++i) {
            if (ci < ncmp && (i >= nrow || (i % stride) == phase)) { const int task = gw + ci * NGW; ++ci;
                cmp_task(Z, KCC, VCT, OCMP, SELM, task >> 9, (task >> 8) & 1, (task + 64 * (task >> 11)) & 255, lane); }
            if (i < nrow) { const int r = gw + i * NGW; select_row(SC, DMASK, r & 15, r >> 4, lane); }
        }
    }
    xcd_barrier(xbar);
#ifndef REP_P4
#define REP_P4 1
#endif
    for (int rep = 0; rep < REP_P4; ++rep)
    for (int r = 0; r * G < 2048; ++r) {
        const int idx = r * G + ((r & 1) ? G - 1 - (int)blockIdx.x : (int)blockIdx.x);
        if (idx >= 2048) continue;
        const unsigned e = TASKTAB[idx]; const int k = (int)(e & 255u), bb = (int)(e >> 8);
        int tid_ = threadIdx.x; asm volatile("" : "+v"(tid_));
        const int lane_ = tid_ & 63;
        if (k < 32) { if (EN_WIN || EN_SLC || EN_CMP) nsa_task(lds, Z, SELM, OCMP, YA, bb >> 1, bb & 1, k, tid_, wave, lane_); }
        else { if (EN_DSA) dsa_task(lds, Z, DMASK, YB, bb, k - 32, tid_, wave, lane_); }
    }
    xcd_barrier(xbar);
    { pg8::Gemm g{YA, Wba_t, MTOK, DM, DM}; pg8::StaticOrder S; S.init(MTOK, DM, G, (int)blockIdx.x); EpiMerge E{Z, MG}; pg8::gemm_phase<EpiMerge, true>(lds, g, S, E); }
    xcd_barrier(xbar);
    { pg8::Gemm g{MG, Wo_t, MTOK, DM, DM}; pg8::StaticOrder S; S.init(MTOK, DM, G, (int)blockIdx.x); EpiResid<1> E{x, nullptr, nullptr, HB, SS1}; pg8::gemm_phase(lds, g, S, E); }
    xcd_barrier(xbar);
    for (int rep = 0; rep < REP_P7; ++rep) { pg8::Gemm g{HB, Wgu_t, MTOK, NGU, DM}; pg8::StaticOrder S; S.init(MTOK, NGU, G, (int)blockIdx.x); EpiGU E{SS1, ACT}; pg8::gemm_phase(lds, g, S, E); }
    xcd_barrier(xbar);
    { pg8::Gemm g{ACT, Wd_t, MTOK, DM, DFF}; pg8::StaticOrder S; S.init(MTOK, DM, G, (int)blockIdx.x);
      EpiDownNorm E{HB, a.out, a.in[16], (unsigned*)SS2, (unsigned*)(a.ws + WS_CTL) + 4096, lds + 131072 + 256}; pg8::gemm_phase(lds, g, S, E); }
}

extern "C" void kernel_launch(void* const* d_in, const int* in_sizes, int n_in, void* d_out, int out_size, void* d_ws, size_t ws_size, hipStream_t stream) {
    static int grid = 0;
    if (grid == 0) {
        int dev = 0, cus = 0, per_cu = 0;
        hipGetDevice(&dev);
        hipDeviceGetAttribute(&cus, hipDeviceAttributeMultiprocessorCount, dev);
        hipFuncSetAttribute((const void*)fwd_kernel, hipFuncAttributeMaxDynamicSharedMemorySize, LDS_BYTES);
        hipOccupancyMaxActiveBlocksPerMultiprocessor(&per_cu, (const void*)fwd_kernel, NTHR, LDS_BYTES);
        if (per_cu < 1) { fprintf(stderr, "occupancy query says %d\n", per_cu); per_cu = 1; }
        if (per_cu > 1) per_cu = 1;
        grid = cus * per_cu;
        if (n_in != 17 || ws_size < WS_END) { fprintf(stderr, "unexpected n_in %d / ws_size %zu\n", n_in, ws_size); }
    }
    hipMemsetAsync((char*)d_ws + WS_CTL, 0, 65536, stream);
    Args a{};
    for (int i = 0; i < 17; ++i) a.in[i] = (const float*)d_in[i];
    a.out = (float*)d_out; a.ws = (unsigned char*)d_ws;
    void* args[] = {&a};
    hipError_t e = hipLaunchCooperativeKernel((const void*)fwd_kernel, dim3(grid), dim3(NTHR), args, LDS_BYTES, stream);
    if (e != hipSuccess) fprintf(stderr, "cooperative launch failed: %s (grid %d)\n", hipGetErrorString(e), grid);
}
```

```cpp
#include <hip/hip_runtime.h>
#include <hip/hip_cooperative_groups.h>
#include <cstdio>
#include <cstdint>
namespace cg = cooperative_groups;

#define LAS __attribute__((address_space(3)))
#define DI __device__ __forceinline__
typedef unsigned short bf16_t;
typedef short bf16x8 __attribute__((ext_vector_type(8)));
typedef short s16x4 __attribute__((ext_vector_type(4)));
typedef float f32x4 __attribute__((ext_vector_type(4)));
typedef float f32x2 __attribute__((ext_vector_type(2)));
typedef float f32x16 __attribute__((ext_vector_type(16)));
typedef unsigned u32x4 __attribute__((ext_vector_type(4)));
typedef unsigned u32x2 __attribute__((ext_vector_type(2)));

constexpr int BATCH = 16, SEQ = 2048, DM = 1024, MTOK = BATCH * SEQ;
constexpr int DIN = 4316, NZ = 4352, DFF = 2816, NGU = 2 * DFF;
constexpr float EPS = 1e-6f;
constexpr int ZC_QA = 0, ZC_KC = 512, ZC_KS = 640, ZC_KW = 768, ZC_QB = 896, ZC_KB = 1408, ZC_IQ = 1472, ZC_IK = 1728;
constexpr int ZC_VC = 1792, ZC_VS = 1920, ZC_VW = 2048, ZC_VB = 2176, ZC_GA = 2240, ZC_IW = 2264, ZC_GM = 2304;
constexpr size_t MiB = 1u << 20;
constexpr size_t WS_WIN = 0, WS_W1K = 9 * MiB, WS_W1V = 10 * MiB, WS_W2K = 11 * MiB, WS_W2V = 11 * MiB + 65536, WS_BIAS1 = 11 * MiB + 131072,
                 WS_ROPE = 11 * MiB + 524288, WS_WBA = 12 * MiB, WS_WBB = 13 * MiB, WS_WO = 14 * MiB, WS_WGU = 16 * MiB, WS_WD = 27 * MiB;
constexpr size_t WS_A = 34 * MiB;
constexpr size_t WS_XN = WS_A, WS_SC = WS_A, WS_T1 = WS_A, WS_MG = WS_A + 64 * MiB, WS_HB = WS_A + 128 * MiB;
constexpr size_t WS_Z = 226 * MiB, WS_ACT = WS_Z;
constexpr size_t WS_KCC = 498 * MiB, WS_VCT = 498 * MiB + 524288, WS_SS1 = 499 * MiB, WS_SS2 = 501 * MiB, WS_CTL = 503 * MiB, WS_END = 504 * MiB;
constexpr size_t OS_OCMP = 0, OS_YA = 32 * MiB, OS_YB = 64 * MiB, OS_DMASK = 96 * MiB, OS_SELM = 104 * MiB;

constexpr int NWAVES = 8, NTHR = 512;
constexpr int LDS_BYTES = 147456;

DI unsigned f2bf(float f) { unsigned u = __builtin_bit_cast(unsigned, f); return (u + 0x7fffu + ((u >> 16) & 1u)) >> 16; }
typedef __bf16 bf16x2_t __attribute__((ext_vector_type(2)));
DI unsigned pk2(float lo, float hi) { const f32x2 v = {lo, hi}; const bf16x2_t b = __builtin_convertvector(v, bf16x2_t); return __builtin_bit_cast(unsigned, b); }
DI float bf2f(unsigned short b) { return __builtin_bit_cast(float, (unsigned)b << 16); }
DI float bflo(unsigned w) { return __builtin_bit_cast(float, w << 16); }
DI float bfhi(unsigned w) { return __builtin_bit_cast(float, w & 0xffff0000u); }
DI float sigmoidf_(float x) { return __builtin_amdgcn_rcpf(1.0f + __expf(-x)); }
DI float dpp_x1(float v) { return __builtin_bit_cast(float, __builtin_amdgcn_update_dpp(0, __builtin_bit_cast(int, v), 0xB1, 0xf, 0xf, true)); }
DI float dpp_x2(float v) { return __builtin_bit_cast(float, __builtin_amdgcn_update_dpp(0, __builtin_bit_cast(int, v), 0x4E, 0xf, 0xf, true)); }
DI unsigned dpp_x1u(unsigned v) { return (unsigned)__builtin_amdgcn_update_dpp(0, (int)v, 0xB1, 0xf, 0xf, true); }
DI unsigned dpp_x2u(unsigned v) { return (unsigned)__builtin_amdgcn_update_dpp(0, (int)v, 0x4E, 0xf, 0xf, true); }
DI float wave_sum(float v) {
#pragma unroll
    for (int o = 1; o < 64; o <<= 1) v += __shfl_xor(v, o);
    return v;
}


#define XB_TMO      128
#define XB_XCNT(j)  (256  + 64 * (j))
#define XB_XSUB(j)  (1280 + 64 * (j))
#define XB_XGEN(j)  (2304 + 64 * (j))
#define XB_TOP      3328
#define XB_TOPGEN   3392
#define XCD_BAR_WORDS 3456
#define XB_SPIN_CAP (1u << 22)
DI unsigned xb_ld(unsigned* p)              { return __hip_atomic_load(p, __ATOMIC_RELAXED, __HIP_MEMORY_SCOPE_AGENT); }
DI unsigned xb_add(unsigned* p, unsigned v) { return __hip_atomic_fetch_add(p, v, __ATOMIC_RELAXED, __HIP_MEMORY_SCOPE_AGENT); }
DI unsigned xb_xcc_id() { return (unsigned)__builtin_amdgcn_s_getreg((3 << 11) | 20) & 0xFu; }
#define XB_SPIN(cond, bar) do { unsigned _sp = 0; while (cond) { __builtin_amdgcn_s_sleep(1); \
    if ((++_sp & 255u) == 0u) { if (xb_ld(&(bar)[XB_TMO])) break; if (_sp > XB_SPIN_CAP) { atomicAdd(&(bar)[XB_TMO], 1u); break; } } } } while (0)
struct XcdBarrier { unsigned* bar; unsigned x; volatile LAS unsigned* st; };
DI XcdBarrier xcd_barrier_post(unsigned* bar, volatile LAS unsigned* st) {
    XcdBarrier b; b.bar = bar; b.x = xb_xcc_id(); b.st = st;
    if (threadIdx.x == 0) (void)xb_add(&bar[XB_XCNT(b.x)], 1u);
    return b;
}
DI void xcd_barrier_complete(unsigned* bar, unsigned x, unsigned& nloc, unsigned& nx) {
    const unsigned G = gridDim.x * gridDim.y * gridDim.z;
    unsigned sum, cnt, mine, sp = 0u;
    for (;;) {
        sum = 0u; cnt = 0u; mine = 0u;
#pragma unroll
        for (unsigned j = 0; j < 16; ++j) { const unsigned c = xb_ld(&bar[XB_XCNT(j)]); sum += c; cnt += (c > 0u) ? 1u : 0u; mine = (j == x) ? c : mine; }
        if (sum == G) break;
        __builtin_amdgcn_s_sleep(1);
        if ((++sp & 255u) == 0u) { if (xb_ld(&bar[XB_TMO])) break; if (sp > XB_SPIN_CAP) { atomicAdd(&bar[XB_TMO], 1u); break; } }
    }
    nloc = mine > 0u ? mine : 1u; nx = cnt > 0u ? cnt : 1u;
}
DI void xcd_barrier(const XcdBarrier& b) {
    asm volatile("s_waitcnt vmcnt(0)" ::: "memory");
    __syncthreads();
    if (threadIdx.x == 0) {
        unsigned* bar = b.bar;
        __builtin_amdgcn_s_waitcnt(0);
        unsigned nloc = b.st[0], nx = b.st[1];
        if (nloc == 0u) { xcd_barrier_complete(bar, b.x, nloc, nx); b.st[0] = nloc; b.st[1] = nx; }
        const unsigned old = xb_add(&bar[XB_XSUB(b.x)], 1u);
        const unsigned gen = old / nloc;
        if (old + 1u == (gen + 1u) * nloc) {
            __builtin_amdgcn_fence(__ATOMIC_RELEASE, "agent");
            asm volatile("s_waitcnt vmcnt(0)" ::: "memory");
            const unsigned og = xb_add(&bar[XB_TOP], 1u);
            const unsigned tg = og / nx;
            if (og + 1u == (tg + 1u) * nx) xb_add(&bar[XB_TOPGEN], 1u);
            else XB_SPIN(xb_ld(&bar[XB_TOPGEN]) == tg, bar);
            __builtin_amdgcn_fence(__ATOMIC_ACQUIRE, "agent");
            xb_add(&bar[XB_XGEN(b.x)], 1u);
            asm volatile("s_waitcnt vmcnt(0)" ::: "memory");
        } else {
            XB_SPIN(xb_ld(&bar[XB_XGEN(b.x)]) == gen, bar);
            __builtin_amdgcn_fence(__ATOMIC_ACQUIRE, "agent");
            asm volatile("s_waitcnt vmcnt(0)" ::: "memory");
        }
    }
    __syncthreads();
}

namespace pg8 {
constexpr int BM = 256, BK = 64, HALF = 128, HTB = HALF * BK * 2, STAGE_BYTES = 8 * HTB, NXCD = 8, WGM = 8;
DI int lds_byte(int r, int c) { const int st = (r >> 4) * 2 + (c >> 5), rr = r & 15, cc = c & 31, ob = rr * 64 + cc * 2; return st * 1024 + (ob ^ (((ob >> 9) & 1) << 5)); }
DI void stage_rc(int b, int& R, int& C) { const int st = b / 1024, sb = b % 1024, swz = sb ^ (((sb >> 9) & 1) << 5); R = (st >> 1) * 16 + swz / 64; C = (st & 1) * 32 + (swz % 64) / 2; }
DI int perm32(int rho) { const int n = rho >> 4, i = rho & 15; return 8 * (i >> 2) + 4 * n + (i & 3); }
struct Unit { int pm, pn; };
struct Gemm { const bf16_t* A; const bf16_t* Bt; int M, N, K; };
struct StaticOrder {
    int nM, nN, nwg, G, c;
    DI void init(int M, int N, int G_, int c_) { nM = M / BM; nN = N / BM; nwg = nM * nN; G = G_; c = c_; }
    DI bool next(int i, Unit& u) const {
        const long L = (long)i * G + c; if (L >= nwg) return false;
        int wgid = (int)L; { const int q = nwg / NXCD, r = nwg % NXCD, xcd = wgid % NXCD, off = wgid / NXCD; wgid = (xcd < r ? xcd * (q + 1) : r * (q + 1) + (xcd - r) * q) + off; }
        const int nig = WGM * nN, gid = wgid / nig, fm = gid * WGM, gsz = (nM - fm) < WGM ? (nM - fm) : WGM;
        u.pm = fm + ((wgid % nig) % gsz); u.pn = (wgid % nig) / gsz; return true;
    }
};
template <class Epi, bool HOOK = false>
DI void gemm_phase(LAS unsigned char* lds, const Gemm g, const StaticOrder& S, const Epi& E) {
    int tid = threadIdx.x; asm volatile("" : "+v"(tid));
    const int wid = __builtin_amdgcn_readfirstlane(tid >> 6), lane = tid & 63, wr = wid >> 2, wc = wid & 3, fr = lane & 15, fq = lane >> 4;
    const int K = g.K, nt = K / BK;
    unsigned voffA[2], voffB[2];
#pragma unroll
    for (int i = 0; i < 2; ++i) { int R, C; stage_rc(tid * 16 + i * 8192, R, C); const int Rb = (R & ~31) + perm32(R & 31);
        voffA[i] = (unsigned)(R * K + C) * 2u; voffB[i] = (unsigned)(Rb * K + C) * 2u; }
    const size_t kstep = (size_t)(BK * 2);
    const size_t hstep = (size_t)HALF * K * 2;
    const size_t tstep = 2 * hstep;
    const unsigned ldsw = (unsigned)wid * 1024u;
    const int aoff = lds_byte(wr * 64 + fr, fq * 8), boff = lds_byte(wc * 32 + fr, fq * 8);
#define PG8_SA(b, h) (((b) * 2 + (h)) * HTB)
#define PG8_SB(b, h) ((4 + (b) * 2 + (h)) * HTB)
#define PG8_STAGE(bufoff, gbase, voff) do { _Pragma("unroll") for (int _i = 0; _i < 2; ++_i) \
        __builtin_amdgcn_global_load_lds((const unsigned*)((const char*)(gbase) + (voff)[_i]), (LAS unsigned*)(lds + (bufoff) + ldsw + _i * 8192), 16, 0, 0); } while (0)
#define PG8_LDA(dst, b, h) do { _Pragma("unroll") for (int m = 0; m < 4; ++m) _Pragma("unroll") for (int k = 0; k < 2; ++k) dst[m][k] = *(const LAS bf16x8*)(lds + PG8_SA(b, h) + aoff + m * 2048 + k * 1024); } while (0)
#define PG8_LDB(dst, b, h) do { _Pragma("unroll") for (int n = 0; n < 2; ++n) _Pragma("unroll") for (int k = 0; k < 2; ++k) dst[n][k] = *(const LAS bf16x8*)(lds + PG8_SB(b, h) + boff + n * 2048 + k * 1024); } while (0)
#define PG8_MMA(ai, bj, At, Bt) do { __builtin_amdgcn_s_setprio(1); _Pragma("unroll") for (int m = 0; m < 4; ++m) _Pragma("unroll") for (int n = 0; n < 2; ++n) _Pragma("unroll") for (int k = 0; k < 2; ++k) \
        acc[ai][bj][m][n] = __builtin_amdgcn_mfma_f32_16x16x32_bf16(Bt[n][k], At[m][k], acc[ai][bj][m][n], 0, 0, 0); __builtin_amdgcn_s_setprio(0); } while (0)
#define PG8_WAIT_V(n) asm volatile("s_waitcnt vmcnt(" #n ")" ::: "memory")
#define PG8_WAIT_L(n) asm volatile("s_waitcnt lgkmcnt(" #n ")" ::: "memory")
#define PG8_BAR __builtin_amdgcn_s_barrier()
#define PG8_SCHED __builtin_amdgcn_sched_barrier(0)
    Unit cur, nxt; int ui = 0;
    if (!S.next(0, cur)) return;
    f32x4 acc[2][2][4][2];
#pragma unroll
    for (int a = 0; a < 2; ++a)
#pragma unroll
        for (int b = 0; b < 2; ++b)
#pragma unroll
            for (int m = 0; m < 4; ++m)
#pragma unroll
                for (int n = 0; n < 2; ++n) acc[a][b][m][n] = (f32x4){0.f, 0.f, 0.f, 0.f};
    bf16x8 At[4][2], B0[2][2], B1[2][2];
    const char* cA = (const char*)g.A + (size_t)cur.pm * tstep; const char* cB = (const char*)g.Bt + (size_t)cur.pn * tstep;
    PG8_STAGE(PG8_SB(0, 0), cB, voffB); PG8_STAGE(PG8_SB(0, 1), cB + hstep, voffB); PG8_STAGE(PG8_SA(0, 0), cA, voffA); PG8_STAGE(PG8_SA(0, 1), cA + hstep, voffA);
    if (wr == 1) PG8_BAR;
    PG8_WAIT_V(2); PG8_BAR;
    PG8_STAGE(PG8_SB(1, 0), cB + kstep, voffB); PG8_STAGE(PG8_SA(1, 0), cA + kstep, voffA); PG8_STAGE(PG8_SB(1, 1), cB + hstep + kstep, voffB);
    PG8_WAIT_V(6); PG8_BAR;
    for (;;) {
        const bool has_next = S.next(ui + 1, nxt);
        const char* nA = has_next ? (const char*)g.A + (size_t)nxt.pm * tstep : cA; const char* nB = has_next ? (const char*)g.Bt + (size_t)nxt.pn * tstep : cB;
#define PG8_KBODY() do { \
            const bool last = (t == nt - 2); \
            const char* a1 = cA + (size_t)(t + 1) * kstep; \
            const char* a2 = last ? nA : cA + (size_t)(t + 2) * kstep; const char* b2 = last ? nB : cB + (size_t)(t + 2) * kstep; \
            const char* a3 = a2 + kstep; const char* b3 = b2 + kstep; \
            PG8_LDB(B0, 0, 0); PG8_LDB(B1, 0, 1); PG8_SCHED; PG8_LDA(At, 0, 0); PG8_STAGE(PG8_SA(1, 1), a1 + hstep, voffA); \
            PG8_WAIT_V(8); PG8_WAIT_L(0); PG8_BAR; PG8_MMA(0, 0, At, B0); PG8_MMA(0, 1, At, B1); PG8_BAR; PG8_SCHED; \
            PG8_LDA(At, 0, 1); PG8_STAGE(PG8_SB(0, 0), b2, voffB); PG8_STAGE(PG8_SB(0, 1), b2 + hstep, voffB); PG8_STAGE(PG8_SA(0, 0), a2, voffA); \
            PG8_WAIT_V(8); PG8_WAIT_L(0); PG8_BAR; PG8_MMA(1, 0, At, B0); PG8_MMA(1, 1, At, B1); PG8_BAR; PG8_SCHED; \
            PG8_LDB(B0, 1, 0); PG8_LDB(B1, 1, 1); PG8_SCHED; PG8_LDA(At, 1, 0); PG8_STAGE(PG8_SA(0, 1), a2 + hstep, voffA); \
            PG8_WAIT_V(8); PG8_WAIT_L(0); PG8_BAR; PG8_MMA(0, 0, At, B0); PG8_MMA(0, 1, At, B1); PG8_BAR; PG8_SCHED; \
            PG8_LDA(At, 1, 1); PG8_STAGE(PG8_SB(1, 0), b3, voffB); PG8_STAGE(PG8_SB(1, 1), b3 + hstep, voffB); PG8_STAGE(PG8_SA(1, 0), a3, voffA); \
            PG8_WAIT_V(8); PG8_WAIT_L(0); PG8_BAR; PG8_MMA(1, 0, At, B0); PG8_MMA(1, 1, At, B1); PG8_BAR; PG8_SCHED; \
        } while (0)
        if constexpr (HOOK) {
            for (int t = 0; t < (nt >> 1); t += 2) PG8_KBODY();
            E.hook(acc, cur, wr, wc, fr, fq);
            for (int t = (nt >> 1); t < nt; t += 2) PG8_KBODY();
        } else {
            for (int t = 0; t < nt; t += 2) PG8_KBODY();
        }
#undef PG8_KBODY
        if (wr == 0) PG8_BAR;
        E(acc, cur, wr, wc, fr, fq);
        if (!has_next) break;
#pragma unroll
        for (int a = 0; a < 2; ++a)
#pragma unroll
            for (int b = 0; b < 2; ++b)
#pragma unroll
                for (int m = 0; m < 4; ++m)
#pragma unroll
                    for (int n = 0; n < 2; ++n) acc[a][b][m][n] = (f32x4){0.f, 0.f, 0.f, 0.f};
        cur = nxt; cA = nA; cB = nB; ++ui;
        if (wr == 1) PG8_BAR;
    }
    PG8_WAIT_V(0);
    PG8_BAR;
#undef PG8_SA
#undef PG8_SB
#undef PG8_STAGE
#undef PG8_LDA
#undef PG8_LDB
#undef PG8_MMA
#undef PG8_WAIT_V
#undef PG8_WAIT_L
#undef PG8_BAR
#undef PG8_SCHED
}
}
using pg8::Unit;
typedef f32x4 Acc[2][2][4][2];

struct EpiInProj {
    bf16_t* Z; const float* ropec; const float* ropes;
    DI void operator()(const Acc& acc, const Unit& u, int wr, int wc, int fr, int fq) const {
        const int row0 = u.pm * 256 + wr * 64 + fr;
        if (u.pn < 7) {
            const int jj = 16 * (wc & 1) + 4 * fq;
#pragma unroll
            for (int ai = 0; ai < 2; ++ai)
#pragma unroll
                for (int m = 0; m < 4; ++m) {
                    const int r = row0 + ai * 128 + m * 16; const int pos = r & (SEQ - 1);
                    const f32x4 c = *(const f32x4*)(ropec + pos * 32 + jj), s = *(const f32x4*)(ropes + pos * 32 + jj);
#pragma unroll
                    for (int bj = 0; bj < 2; ++bj) {
                        const f32x4 x1 = acc[ai][bj][m][0], x2 = acc[ai][bj][m][1];
                        const f32x4 o1 = x1 * c - x2 * s, o2 = x1 * s + x2 * c;
                        bf16_t* p = Z + (size_t)r * NZ + u.pn * 256 + bj * 128 + (wc >> 1) * 64 + jj;
                        u32x2 w1; w1.x = pk2(o1[0], o1[1]); w1.y = pk2(o1[2], o1[3]);
                        u32x2 w2; w2.x = pk2(o2[0], o2[1]); w2.y = pk2(o2[2], o2[3]);
                        *(u32x2*)p = w1; *(u32x2*)(p + 32) = w2;
                    }
                }
        } else {
#pragma unroll
            for (int ai = 0; ai < 2; ++ai)
#pragma unroll
                for (int m = 0; m < 4; ++m) {
                    const int r = row0 + ai * 128 + m * 16;
#pragma unroll
                    for (int bj = 0; bj < 2; ++bj) {
                        const f32x4 v0 = acc[ai][bj][m][0], v1 = acc[ai][bj][m][1];
                        u32x4 w; w.x = pk2(v0[0], v0[1]); w.y = pk2(v0[2], v0[3]); w.z = pk2(v1[0], v1[1]); w.w = pk2(v1[2], v1[3]);
                        *(u32x4*)(Z + (size_t)r * NZ + u.pn * 256 + bj * 128 + wc * 32 + 8 * fq) = w;
                    }
                }
        }
    }
};
template <int SECOND> struct EpiGate {
    const bf16_t* Z; bf16_t* T1; bf16_t* MG;
    DI void operator()(const Acc& acc, const Unit& u, int wr, int wc, int fr, int fq) const {
        const int row0 = u.pm * 256 + wr * 64 + fr;
#pragma unroll
        for (int ai = 0; ai < 2; ++ai)
#pragma unroll
            for (int m = 0; m < 4; ++m) {
                const int r = row0 + ai * 128 + m * 16;
#pragma unroll
                for (int bj = 0; bj < 2; ++bj) {
                    const int c0 = u.pn * 256 + bj * 128 + wc * 32 + 8 * fq;
                    const u32x4 gw = *(const u32x4*)(Z + (size_t)r * NZ + ZC_GM + SECOND * DM + c0);
                    const f32x4 v0 = acc[ai][bj][m][0], v1 = acc[ai][bj][m][1];
                    float o[8];
                    o[0] = v0[0] * sigmoidf_(bflo(gw.x)); o[1] = v0[1] * sigmoidf_(bfhi(gw.x)); o[2] = v0[2] * sigmoidf_(bflo(gw.y)); o[3] = v0[3] * sigmoidf_(bfhi(gw.y));
                    o[4] = v1[0] * sigmoidf_(bflo(gw.z)); o[5] = v1[1] * sigmoidf_(bfhi(gw.z)); o[6] = v1[2] * sigmoidf_(bflo(gw.w)); o[7] = v1[3] * sigmoidf_(bfhi(gw.w));
                    if (SECOND) {
                        const u32x4 t = *(const u32x4*)(T1 + (size_t)r * DM + c0);
                        o[0] += bflo(t.x); o[1] += bfhi(t.x); o[2] += bflo(t.y); o[3] += bfhi(t.y); o[4] += bflo(t.z); o[5] += bfhi(t.z); o[6] += bflo(t.w); o[7] += bfhi(t.w);
                    }
                    u32x4 w; w.x = pk2(o[0], o[1]); w.y = pk2(o[2], o[3]); w.z = pk2(o[4], o[5]); w.w = pk2(o[6], o[7]);
                    *(u32x4*)((SECOND ? MG : T1) + (size_t)r * DM + c0) = w;
                }
            }
    }
};
struct EpiMerge {
    const bf16_t* Z; bf16_t* MG;
    DI void hook(Acc& acc, const Unit& u, int wr, int wc, int fr, int fq) const {
        const int row0 = u.pm * 256 + wr * 64 + fr;
#pragma unroll
        for (int ai = 0; ai < 2; ++ai)
#pragma unroll
            for (int m = 0; m < 4; ++m) {
                const int r = row0 + ai * 128 + m * 16;
#pragma unroll
                for (int bj = 0; bj < 2; ++bj) {
                    const int c0 = u.pn * 256 + bj * 128 + wc * 32 + 8 * fq;
                    const u32x4 ga = *(const u32x4*)(Z + (size_t)r * NZ + ZC_GM + c0), gb = *(const u32x4*)(Z + (size_t)r * NZ + ZC_GM + DM + c0);
                    float ra[8];
                    const unsigned gaw[4] = {ga.x, ga.y, ga.z, ga.w}, gbw[4] = {gb.x, gb.y, gb.z, gb.w};
#pragma unroll
                    for (int q = 0; q < 4; ++q) {
                        ra[2 * q] = (1.0f + __expf(-bflo(gbw[q]))) * __builtin_amdgcn_rcpf(1.0f + __expf(-bflo(gaw[q])));
                        ra[2 * q + 1] = (1.0f + __expf(-bfhi(gbw[q]))) * __builtin_amdgcn_rcpf(1.0f + __expf(-bfhi(gaw[q])));
                    }
                    acc[ai][bj][m][0] = acc[ai][bj][m][0] * (f32x4){ra[0], ra[1], ra[2], ra[3]};
                    acc[ai][bj][m][1] = acc[ai][bj][m][1] * (f32x4){ra[4], ra[5], ra[6], ra[7]};
                }
                asm volatile("" ::: "memory");
            }
    }
    DI void operator()(const Acc& acc, const Unit& u, int wr, int wc, int fr, int fq) const {
        int row0 = u.pm * 256 + wr * 64 + fr; asm volatile("" : "+v"(row0));
#pragma unroll
        for (int ai = 0; ai < 2; ++ai)
#pragma unroll
            for (int m = 0; m < 4; ++m) {
                const int r = row0 + ai * 128 + m * 16;
#pragma unroll
                for (int bj = 0; bj < 2; ++bj) {
                    const int c0 = u.pn * 256 + bj * 128 + wc * 32 + 8 * fq;
                    const u32x4 gw = *(const u32x4*)(Z + (size_t)r * NZ + ZC_GM + DM + c0);
                    const f32x4 v0 = acc[ai][bj][m][0], v1 = acc[ai][bj][m][1];
                    u32x4 w;
                    w.x = pk2(v0[0] * sigmoidf_(bflo(gw.x)), v0[1] * sigmoidf_(bfhi(gw.x))); w.y = pk2(v0[2] * sigmoidf_(bflo(gw.y)), v0[3] * sigmoidf_(bfhi(gw.y)));
                    w.z = pk2(v1[0] * sigmoidf_(bflo(gw.z)), v1[1] * sigmoidf_(bfhi(gw.z))); w.w = pk2(v1[2] * sigmoidf_(bflo(gw.w)), v1[3] * sigmoidf_(bfhi(gw.w)));
                    *(u32x4*)(MG + (size_t)r * DM + c0) = w;
                }
            }
    }
};
template <int MODE> struct EpiResid {
    const float* base; const bf16_t* baseb; float* H; bf16_t* HB; float* SS;
    DI void operator()(const Acc& acc, const Unit& u, int wr, int wc, int fr, int fq) const {
        const int row0 = u.pm * 256 + wr * 64 + fr;
#pragma unroll
        for (int ai = 0; ai < 2; ++ai)
#pragma unroll
            for (int m = 0; m < 4; ++m) {
                const int r = row0 + ai * 128 + m * 16; float ss = 0.f;
#pragma unroll
                for (int bj = 0; bj < 2; ++bj) {
                    const int c0 = u.pn * 256 + bj * 128 + wc * 32 + 8 * fq; const size_t off = (size_t)r * DM + c0;
                    f32x4 b0, b1;
                    if (MODE == 1) { b0 = *(const f32x4*)(base + off); b1 = *(const f32x4*)(base + off + 4); }
                    else { const u32x4 w = *(const u32x4*)(baseb + off); b0 = (f32x4){bflo(w.x), bfhi(w.x), bflo(w.y), bfhi(w.y)}; b1 = (f32x4){bflo(w.z), bfhi(w.z), bflo(w.w), bfhi(w.w)}; }
                    const f32x4 h0 = b0 + acc[ai][bj][m][0], h1 = b1 + acc[ai][bj][m][1];
                    ss += (h0[0] * h0[0] + h0[1] * h0[1]) + (h0[2] * h0[2] + h0[3] * h0[3]) + (h1[0] * h1[0] + h1[1] * h1[1]) + (h1[2] * h1[2] + h1[3] * h1[3]);
                    if (MODE == 1) { u32x4 w; w.x = pk2(h0[0], h0[1]); w.y = pk2(h0[2], h0[3]); w.z = pk2(h1[0], h1[1]); w.w = pk2(h1[2], h1[3]); *(u32x4*)(HB + off) = w; }
                    else { u32x4 w; w.x = pk2(h0[0], h0[1]); w.y = pk2(h0[2], h0[3]); w.z = pk2(h1[0], h1[1]); w.w = pk2(h1[2], h1[3]); *(u32x4*)(HB + off) = w; }
                }
                ss += __shfl_xor(ss, 16); ss += __shfl_xor(ss, 32);
                if (fq == 0) SS[(size_t)r * 16 + u.pn * 4 + wc] = ss;
            }
    }
};
struct EpiDownNorm {
    const bf16_t* baseb; float* OUT; const float* gfin; unsigned* xslot; unsigned* cnt; LAS unsigned char* ldsx;
    DI void operator()(Acc& acc, const Unit& u, int wr, int wc, int fr, int fq) const {
        const int lane = fr + 16 * fq, wid = wr * 4 + wc, tid = wid * 64 + lane;
        LAS float* P = (LAS float*)ldsx;
        LAS float* S = (LAS float*)(ldsx + 4096);
        const int rl0 = wr * 64 + fr;
#pragma unroll
        for (int ai = 0; ai < 2; ++ai)
#pragma unroll
            for (int m = 0; m < 4; ++m) {
                const int rl = rl0 + ai * 128 + m * 16; const int r = u.pm * 256 + rl; float ss = 0.f;
#pragma unroll
                for (int bj = 0; bj < 2; ++bj) {
                    const int c0 = u.pn * 256 + bj * 128 + wc * 32 + 8 * fq;
                    const u32x4 w = *(const u32x4*)(baseb + (size_t)r * DM + c0);
                    const f32x4 h0 = (f32x4){bflo(w.x), bfhi(w.x), bflo(w.y), bfhi(w.y)} + acc[ai][bj][m][0], h1 = (f32x4){bflo(w.z), bfhi(w.z), bflo(w.w), bfhi(w.w)} + acc[ai][bj][m][1];
                    acc[ai][bj][m][0] = h0; acc[ai][bj][m][1] = h1;
                    ss += (h0[0] * h0[0] + h0[1] * h0[1]) + (h0[2] * h0[2] + h0[3] * h0[3]) + (h1[0] * h1[0] + h1[1] * h1[1]) + (h1[2] * h1[2] + h1[3] * h1[3]);
                }
                ss += __shfl_xor(ss, 16); ss += __shfl_xor(ss, 32);
                if (fq == 0) P[rl * 4 + wc] = ss;
            }
        asm volatile("s_waitcnt lgkmcnt(0)" ::: "memory"); __builtin_amdgcn_s_barrier(); asm volatile("" ::: "memory");
        if (tid < 256) {
            const float s = (P[tid * 4 + 0] + P[tid * 4 + 1]) + (P[tid * 4 + 2] + P[tid * 4 + 3]);
            __hip_atomic_store(xslot + (size_t)(u.pm * 256 + tid) * 4 + u.pn, __builtin_bit_cast(unsigned, s), __ATOMIC_RELAXED, __HIP_MEMORY_SCOPE_AGENT);
        }
        asm volatile("s_waitcnt vmcnt(0)" ::: "memory");
        if (lane == 0) __hip_atomic_fetch_add(cnt + 64 * u.pm, 1u, __ATOMIC_RELAXED, __HIP_MEMORY_SCOPE_AGENT);
        if (wid == 0) {
            unsigned sp = 0;
            while ((unsigned)__builtin_amdgcn_readfirstlane(__hip_atomic_load(cnt + 64 * u.pm, __ATOMIC_RELAXED, __HIP_MEMORY_SCOPE_AGENT)) < 32u) { __builtin_amdgcn_s_sleep(2); if (++sp > (1u << 22)) break; }
        }
        asm volatile("s_waitcnt vmcnt(0) lgkmcnt(0)" ::: "memory"); __builtin_amdgcn_s_barrier(); asm volatile("" ::: "memory");
        if (tid < 256) {
            const unsigned* sl = xslot + (size_t)(u.pm * 256 + tid) * 4; float tot = 0.f;
#pragma unroll
            for (int t = 0; t < 4; ++t) tot += __builtin_bit_cast(float, __hip_atomic_load(sl + t, __ATOMIC_RELAXED, __HIP_MEMORY_SCOPE_AGENT));
            S[tid] = 1.0f / sqrtf(tot * (1.0f / DM) + EPS);
        }
        asm volatile("s_waitcnt vmcnt(0) lgkmcnt(0)" ::: "memory"); __builtin_amdgcn_s_barrier(); asm volatile("" ::: "memory");
#pragma unroll
        for (int bj = 0; bj < 2; ++bj) {
            const int c0 = u.pn * 256 + bj * 128 + wc * 32 + 8 * fq;
            const f32x4 g0 = *(const f32x4*)(gfin + c0), g1 = *(const f32x4*)(gfin + c0 + 4);
#pragma unroll
            for (int ai = 0; ai < 2; ++ai)
#pragma unroll
                for (int m = 0; m < 4; ++m) {
                    const int rl = rl0 + ai * 128 + m * 16; const float rr = S[rl]; float* o = OUT + (size_t)(u.pm * 256 + rl) * DM + c0;
                    *(f32x4*)o = acc[ai][bj][m][0] * rr * g0; *(f32x4*)(o + 4) = acc[ai][bj][m][1] * rr * g1;
                }
        }
    }
};
struct EpiGU {
    const float* SS; bf16_t* ACT;
    DI void operator()(const Acc& acc, const Unit& u, int wr, int wc, int fr, int fq) const {
        const int row0 = u.pm * 256 + wr * 64 + fr;
#pragma unroll
        for (int ai = 0; ai < 2; ++ai)
#pragma unroll
            for (int m = 0; m < 4; ++m) {
                const int r = row0 + ai * 128 + m * 16;
                const f32x4* sp = (const f32x4*)(SS + (size_t)r * 16);
                const f32x4 s0 = sp[0], s1 = sp[1], s2 = sp[2], s3 = sp[3];
                const float tot = ((s0[0] + s0[1]) + (s0[2] + s0[3])) + ((s1[0] + s1[1]) + (s1[2] + s1[3])) + ((s2[0] + s2[1]) + (s2[2] + s2[3])) + ((s3[0] + s3[1]) + (s3[2] + s3[3]));
                const float rr = 1.0f / sqrtf(tot * (1.0f / DM) + EPS);
#pragma unroll
                for (int bj = 0; bj < 2; ++bj) {
                    const int f0 = u.pn * 128 + bj * 64 + wc * 16 + 4 * fq;
                    const f32x4 g = acc[ai][bj][m][0] * rr, up = acc[ai][bj][m][1] * rr;
                    float o[4];
#pragma unroll
                    for (int i = 0; i < 4; ++i) o[i] = g[i] * sigmoidf_(g[i]) * up[i];
                    u32x2 w; w.x = pk2(o[0], o[1]); w.y = pk2(o[2], o[3]);
                    *(u32x2*)(ACT + (size_t)r * DFF + f0) = w;
                }
            }
    }
};


#ifndef EN_DSA
#define EN_DSA 1
#endif
#ifndef EN_WIN
#define EN_WIN 1
#endif
#ifndef EN_SLC
#define EN_SLC 1
#endif
#ifndef EN_CMP
#define EN_CMP 1
#endif
#define MFMA32(a, b, c) __builtin_amdgcn_mfma_f32_32x32x16_bf16((a), (b), (c), 0, 0, 0)
typedef short v4i16_t __attribute__((ext_vector_type(4)));
constexpr float SM_C = 0.125f * 1.4426950408889634f;
constexpr float NINF = -__builtin_inff();
DI int crow(int r, int h) { return (r & 3) + 8 * (r >> 2) + 4 * h; }
DI float fexp2(float x) { return __builtin_amdgcn_exp2f(x); }
DI s16x4 vtr(const LAS unsigned char* p) { return __builtin_bit_cast(s16x4, __builtin_amdgcn_ds_read_tr16_b64_v4i16((LAS v4i16_t*)p)); }
DI bf16x8 pack8(const f32x16& p, int s) {
    u32x4 w; w.x = pk2(p[8 * s], p[8 * s + 1]); w.y = pk2(p[8 * s + 2], p[8 * s + 3]); w.z = pk2(p[8 * s + 4], p[8 * s + 5]); w.w = pk2(p[8 * s + 6], p[8 * s + 7]);
    return __builtin_bit_cast(bf16x8, w);
}
DI f32x16 f16zero() { f32x16 z;
#pragma unroll
    for (int i = 0; i < 16; ++i) z[i] = 0.f;
    return z; }
struct FState { f32x16 o0, o1; float m, l; };
DI void fs_reset(FState& st) { st.o0 = f16zero(); st.o1 = f16zero(); st.m = NINF; st.l = 0.f; }
DI void flash_qk_bias(const LAS unsigned char* kb, const bf16x8 (&qf)[4], f32x16& p0, f32x16& p1, int r32, int h, const bf16x8& m0, const bf16x8& m1, const bf16x8& ef) {
    p0 = MFMA32(m0, ef, f16zero()); p1 = MFMA32(m1, ef, f16zero());
    const int sw = (r32 >> 1) & 7;
#pragma unroll
    for (int s = 0; s < 4; ++s) {
        const int off = r32 * 128 + (((2 * s + h) ^ sw) << 4);
        const bf16x8 a0 = *(const LAS bf16x8*)(kb + off), a1 = *(const LAS bf16x8*)(kb + off + 4096);
        p0 = MFMA32(a0, qf[s], p0); p1 = MFMA32(a1, qf[s], p1);
    }
}
DI void flash_qk(const LAS unsigned char* kb, const bf16x8 (&qf)[4], f32x16& p0, f32x16& p1, int r32, int h) {
    p0 = f16zero(); p1 = f16zero();
    const int sw = (r32 >> 1) & 7;
#pragma unroll
    for (int s = 0; s < 4; ++s) {
        const int off = r32 * 128 + (((2 * s + h) ^ sw) << 4);
        const bf16x8 a0 = *(const LAS bf16x8*)(kb + off), a1 = *(const LAS bf16x8*)(kb + off + 4096);
        p0 = MFMA32(a0, qf[s], p0); p1 = MFMA32(a1, qf[s], p1);
    }
}
DI unsigned cvtpk(float lo, float hi) { const f32x2 v = {lo, hi}; const bf16x2_t b = __builtin_convertvector(v, bf16x2_t); return __builtin_bit_cast(unsigned, b); }
DI bf16x8 pack8h(const f32x16& p, int s) {
    u32x4 w; w.x = cvtpk(p[8 * s], p[8 * s + 1]); w.y = cvtpk(p[8 * s + 2], p[8 * s + 3]); w.z = cvtpk(p[8 * s + 4], p[8 * s + 5]); w.w = cvtpk(p[8 * s + 6], p[8 * s + 7]);
    return __builtin_bit_cast(bf16x8, w);
}
DI float half_max(float v) { return fmaxf(v, __shfl_xor(v, 32)); }
DI float half_sum(float v) { return v + __shfl_xor(v, 32); }
constexpr float THR_RAW = 8.0f / SM_C;
DI void flash_pv(FState& st, f32x16& p0, f32x16& p1, bool rowon, const LAS unsigned char* vb, int lane) {
    float mx = fmaxf(p0[0], p1[0]);
#pragma unroll
    for (int r = 1; r < 16; ++r) asm("v_max3_f32 %0, %1, %2, %3" : "=v"(mx) : "v"(mx), "v"(p0[r]), "v"(p1[r]));
    mx = half_max(mx);
    mx = rowon ? mx : NINF;
    const bool upd = mx > st.m + THR_RAW;
    if (__any(upd)) {
        const float mn = upd ? mx : st.m;
        const float alpha = upd ? fexp2((st.m - mn) * SM_C) : 1.0f;
        st.m = mn; st.l *= alpha;
#pragma unroll
        for (int r = 0; r < 16; ++r) { st.o0[r] *= alpha; st.o1[r] *= alpha; }
    }
    const float cl = rowon ? SM_C : 0.0f;
    const float bl = rowon ? ((st.m == NINF) ? 0.0f : -st.m * SM_C) : NINF;
    float sum = 0.f;
#pragma unroll
    for (int r = 0; r < 16; ++r) { p0[r] = fexp2(__builtin_fmaf(p0[r], cl, bl)); p1[r] = fexp2(__builtin_fmaf(p1[r], cl, bl)); sum += p0[r] + p1[r]; }
    st.l += sum;
    const int h = lane >> 5;
    const int vx = (((lane & 15) >> 3) & 1) * 64;
    const LAS unsigned char* vp = vb + (4 * h + ((lane & 15) >> 2)) * 128 + ((lane >> 4) & 1) * 32 + (lane & 3) * 8;
#pragma unroll
    for (int sub = 0; sub < 2; ++sub)
#pragma unroll
        for (int s2 = 0; s2 < 2; ++s2) {
            const bf16x8 pf = pack8h(sub ? p1 : p0, s2);
            const LAS unsigned char* vq = vp + (32 * sub + 16 * s2) * 128;
            { const s16x4 lo = vtr(vq + vx), hi = vtr(vq + 1024 + vx); const bf16x8 vf = {lo[0], lo[1], lo[2], lo[3], hi[0], hi[1], hi[2], hi[3]}; st.o0 = MFMA32(vf, pf, st.o0); }
            { const s16x4 lo = vtr(vq + (64 - vx)), hi = vtr(vq + 1024 + (64 - vx)); const bf16x8 vf = {lo[0], lo[1], lo[2], lo[3], hi[0], hi[1], hi[2], hi[3]}; st.o1 = MFMA32(vf, pf, st.o1); }
        }
}
DI void flash_pv2(FState& sa, FState& sb, f32x16& a0, f32x16& a1, bool rona, f32x16& b0, f32x16& b1, bool ronb, const LAS unsigned char* va, const LAS unsigned char* vbb, int lane) {
    float mxa = fmaxf(a0[0], a1[0]), mxb = fmaxf(b0[0], b1[0]);
#pragma unroll
    for (int r = 1; r < 16; ++r) { asm("v_max3_f32 %0, %1, %2, %3" : "=v"(mxa) : "v"(mxa), "v"(a0[r]), "v"(a1[r])); asm("v_max3_f32 %0, %1, %2, %3" : "=v"(mxb) : "v"(mxb), "v"(b0[r]), "v"(b1[r])); }
    mxa = half_max(mxa); mxb = half_max(mxb);
    mxa = rona ? mxa : NINF; mxb = ronb ? mxb : NINF;
    const bool upa = mxa > sa.m + THR_RAW, upb = mxb > sb.m + THR_RAW;
    if (__any(upa || upb)) {
        const float mna = upa ? mxa : sa.m, mnb = upb ? mxb : sb.m;
        const float ala = upa ? fexp2((sa.m - mna) * SM_C) : 1.0f, alb = upb ? fexp2((sb.m - mnb) * SM_C) : 1.0f;
        sa.m = mna; sa.l *= ala; sb.m = mnb; sb.l *= alb;
#pragma unroll
        for (int r = 0; r < 16; ++r) { sa.o0[r] *= ala; sa.o1[r] *= ala; sb.o0[r] *= alb; sb.o1[r] *= alb; }
    }
    const float cla = rona ? SM_C : 0.0f, bla = rona ? ((sa.m == NINF) ? 0.0f : -sa.m * SM_C) : NINF;
    const float clb = ronb ? SM_C : 0.0f, blb = ronb ? ((sb.m == NINF) ? 0.0f : -sb.m * SM_C) : NINF;
    float suma = 0.f, sumb = 0.f;
#pragma unroll
    for (int r = 0; r < 16; ++r) {
        a0[r] = fexp2(__builtin_fmaf(a0[r], cla, bla)); b0[r] = fexp2(__builtin_fmaf(b0[r], clb, blb));
        a1[r] = fexp2(__builtin_fmaf(a1[r], cla, bla)); b1[r] = fexp2(__builtin_fmaf(b1[r], clb, blb));
        suma += a0[r] + a1[r]; sumb += b0[r] + b1[r];
    }
    sa.l += suma; sb.l += sumb;
    const int h = lane >> 5;
    const int vx = (((lane & 15) >> 3) & 1) * 64;
    const int voff = (4 * h + ((lane & 15) >> 2)) * 128 + ((lane >> 4) & 1) * 32 + (lane & 3) * 8;
#pragma unroll
    for (int sub = 0; sub < 2; ++sub)
#pragma unroll
        for (int s2 = 0; s2 < 2; ++s2) {
            const bf16x8 pfa = pack8h(sub ? a1 : a0, s2), pfb = pack8h(sub ? b1 : b0, s2);
            const LAS unsigned char* qa = va + voff + (32 * sub + 16 * s2) * 128; const LAS unsigned char* qb = vbb + voff + (32 * sub + 16 * s2) * 128;
            { const s16x4 lo = vtr(qa + vx), hi = vtr(qa + 1024 + vx); const bf16x8 vf = {lo[0], lo[1], lo[2], lo[3], hi[0], hi[1], hi[2], hi[3]}; sa.o0 = MFMA32(vf, pfa, sa.o0); }
            { const s16x4 lo = vtr(qb + vx), hi = vtr(qb + 1024 + vx); const bf16x8 vf = {lo[0], lo[1], lo[2], lo[3], hi[0], hi[1], hi[2], hi[3]}; sb.o0 = MFMA32(vf, pfb, sb.o0); }
            { const s16x4 lo = vtr(qa + (64 - vx)), hi = vtr(qa + 1024 + (64 - vx)); const bf16x8 vf = {lo[0], lo[1], lo[2], lo[3], hi[0], hi[1], hi[2], hi[3]}; sa.o1 = MFMA32(vf, pfa, sa.o1); }
            { const s16x4 lo = vtr(qb + (64 - vx)), hi = vtr(qb + 1024 + (64 - vx)); const bf16x8 vf = {lo[0], lo[1], lo[2], lo[3], hi[0], hi[1], hi[2], hi[3]}; sb.o1 = MFMA32(vf, pfb, sb.o1); }
        }
}
DI void fs_merge(FState& sa, const FState& sb) {
    const float m = fmaxf(sa.m, sb.m), mu = (m == NINF) ? 0.0f : m;
    const float fa = fexp2((sa.m - mu) * SM_C), fb = fexp2((sb.m - mu) * SM_C);
    sa.m = m; sa.l = sa.l * fa + sb.l * fb;
#pragma unroll
    for (int r = 0; r < 16; ++r) { sa.o0[r] = sa.o0[r] * fa + sb.o0[r] * fb; sa.o1[r] = sa.o1[r] * fa + sb.o1[r] * fb; }
}
DI void store_y(bf16_t* dst, const f32x16& y0, const f32x16& y1, int h) {
#pragma unroll
    for (int mm = 0; mm < 4; ++mm) {
        u32x2 w0; w0.x = pk2(y0[4 * mm], y0[4 * mm + 1]); w0.y = pk2(y0[4 * mm + 2], y0[4 * mm + 3]);
        u32x2 w1; w1.x = pk2(y1[4 * mm], y1[4 * mm + 1]); w1.y = pk2(y1[4 * mm + 2], y1[4 * mm + 3]);
        *(u32x2*)(dst + 8 * mm + 4 * h) = w0; *(u32x2*)(dst + 32 + 8 * mm + 4 * h) = w1;
    }
}

DI void nsa_task(LAS unsigned char* lds, const bf16_t* Z, const unsigned* selm, const bf16_t* OCMP, bf16_t* YA, int b, int hk, int c, int tid, int wave, int lane) {
    const int r32 = lane & 31, h = lane >> 5;
    const int tok = 64 * c + 8 * wave + (r32 >> 2), head = hk * 4 + (r32 & 3);
    const size_t grow = (size_t)b * SEQ + tok;
    const bf16_t* zr = Z + grow * NZ;
    bf16x8 qf[4];
#pragma unroll
    for (int s = 0; s < 4; ++s) qf[s] = *(const bf16x8*)(zr + ZC_QA + head * 64 + 16 * s + 8 * h);
    const unsigned selw = EN_SLC ? selm[grow * 2 + hk] : 0u;
    const float g_cmp = sigmoidf_(bf2f(zr[ZC_GA + head])), g_slc = sigmoidf_(bf2f(zr[ZC_GA + 8 + head])), g_win = sigmoidf_(bf2f(zr[ZC_GA + 16 + head]));
    f32x16 y0 = f16zero(), y1 = f16zero();
    FState st; fs_reset(st);
    const int nsel = EN_SLC ? c + 1 : 0, nwin = EN_WIN ? (c + 1 < 9 ? c + 1 : 9) : 0, ntot = nsel + nwin;
    const int skey = tid >> 3, sch = tid & 7;
    const int kdst = skey * 128 + ((sch ^ ((skey >> 1) & 7)) << 4), vdst = 8192 + skey * 128 + ((sch * 16) ^ (((skey >> 1) & 1) << 6));
    const bf16_t* sbase = Z + ((size_t)b * SEQ + skey) * NZ + hk * 64 + sch * 8;
    u32x4 kA = {0u, 0u, 0u, 0u}, vA = kA, kB = kA, vB = kA, kC = kA, vC = kA;
#define NSA_LOADT(it_, KR, VR) do { const int i_ = (it_); if (i_ < ntot) { const bool s_ = i_ < nsel; const int j_ = s_ ? i_ : c - (i_ - nsel); const bf16_t* p_ = sbase + (size_t)(64 * j_) * NZ; \
        KR = *(const u32x4*)(p_ + (s_ ? ZC_KS : ZC_KW)); VR = *(const u32x4*)(p_ + (s_ ? ZC_VS : ZC_VW)); } } while (0)
#define NSA_FINAL(gate_) do { const float lt_ = half_sum(st.l); const float inv_ = lt_ > 0.f ? (gate_) / lt_ : 0.f; \
        _Pragma("unroll") for (int r = 0; r < 16; ++r) { y0[r] += st.o0[r] * inv_; y1[r] += st.o1[r] * inv_; } fs_reset(st); } while (0)
#define NSA_STEP(it_, KR, VR) do { const int it = (it_); \
        LAS unsigned char* buf = lds + (it & 1) * 16384; \
        *(LAS u32x4*)(buf + kdst) = KR; *(LAS u32x4*)(buf + vdst) = VR; \
        __syncthreads(); \
        NSA_LOADT(it + 3, KR, VR); \
        if (it == nsel && nsel > 0) NSA_FINAL(g_slc); \
        const bool is_sel = it < nsel; const int j = is_sel ? it : c - (it - nsel); \
        f32x16 p0, p1; flash_qk(buf, qf, p0, p1, r32, h); \
        const int kb0 = 64 * j + 4 * h; \
        bool rowon = true; \
        if (is_sel) { \
            rowon = (selw >> j) & 1u; \
            if (j == c) { \
                _Pragma("unroll") for (int r = 0; r < 16; ++r) { const int kp = kb0 + (r & 3) + 8 * (r >> 2); p0[r] = (kp <= tok) ? p0[r] : NINF; p1[r] = (kp + 32 <= tok) ? p1[r] : NINF; } \
            } \
        } else if (j == c || j == c - 8) { \
            _Pragma("unroll") for (int r = 0; r < 16; ++r) { const int kp = kb0 + (r & 3) + 8 * (r >> 2); \
                p0[r] = (kp <= tok && kp > tok - 512) ? p0[r] : NINF; p1[r] = (kp + 32 <= tok && kp + 32 > tok - 512) ? p1[r] : NINF; } \
        } \
        flash_pv(st, p0, p1, rowon, buf + 8192, lane); } while (0)
    NSA_LOADT(0, kA, vA); NSA_LOADT(1, kB, vB); NSA_LOADT(2, kC, vC);
    for (int it0 = 0; it0 < ntot; it0 += 3) {
        NSA_STEP(it0, kA, vA);
        if (it0 + 1 < ntot) NSA_STEP(it0 + 1, kB, vB);
        if (it0 + 2 < ntot) NSA_STEP(it0 + 2, kC, vC);
    }
    if (nwin > 0) NSA_FINAL(g_win); else if (nsel > 0) NSA_FINAL(g_slc);
    if (EN_CMP) {
        const bf16_t* oc = OCMP + grow * 512 + head * 64;
#pragma unroll
        for (int mm = 0; mm < 4; ++mm) {
            const u32x2 w0 = *(const u32x2*)(oc + 8 * mm + 4 * h), w1 = *(const u32x2*)(oc + 32 + 8 * mm + 4 * h);
            y0[4 * mm] += g_cmp * bflo(w0.x); y0[4 * mm + 1] += g_cmp * bfhi(w0.x); y0[4 * mm + 2] += g_cmp * bflo(w0.y); y0[4 * mm + 3] += g_cmp * bfhi(w0.y);
            y1[4 * mm] += g_cmp * bflo(w1.x); y1[4 * mm + 1] += g_cmp * bfhi(w1.x); y1[4 * mm + 2] += g_cmp * bflo(w1.y); y1[4 * mm + 3] += g_cmp * bfhi(w1.y);
        }
    }
    store_y(YA + grow * 1024 + head * 64, y0, y1, h);
    __syncthreads();
#undef NSA_LOADT
#undef NSA_FINAL
#undef NSA_STEP
}

DI void dsa_task(LAS unsigned char* lds, const bf16_t* Z, const unsigned* dmask, bf16_t* YB, int b, int qi, int tid, int wave, int lane) {
    const int r32 = lane & 31, h = lane >> 5;
    const int tok = 32 * qi + 4 * wave + (r32 >> 3), head = r32 & 7;
    const size_t grow = (size_t)b * SEQ + tok;
    const bf16_t* zr = Z + grow * NZ;
    bf16x8 qf[4];
#pragma unroll
    for (int s = 0; s < 4; ++s) qf[s] = *(const bf16x8*)(zr + ZC_QB + head * 64 + 16 * s + 8 * h);
    const unsigned* dmw = dmask + ((size_t)b * SEQ + 32 * qi + 4 * wave) * 64;
    FState st, sb; fs_reset(st); fs_reset(sb);
    const int ntot = (qi >> 1) + 1, npair = (ntot + 1) >> 1;
    const int skey = tid >> 3, sch = tid & 7;
    const bf16_t* srow = Z + ((size_t)b * SEQ + skey) * NZ;
    const int kch = (sch ^ ((skey >> 1) & 7)) * 8, vch = (sch ^ (((skey >> 1) & 1) << 2)) * 8;
    const int wbase = wave * 1024;
#define DSA_DMA(p_) do { const int pp_ = (p_); if (pp_ < npair) { const int t0_ = 2 * pp_, t1_ = (2 * pp_ + 1 < ntot) ? 2 * pp_ + 1 : ntot - 1; LAS unsigned char* st_ = lds + (pp_ & 1) * 32768 + wbase; \
        const bf16_t* q0_ = srow + (size_t)(64 * t0_) * NZ; const bf16_t* q1_ = srow + (size_t)(64 * t1_) * NZ; \
        __builtin_amdgcn_global_load_lds((const unsigned*)(q0_ + ZC_KB + kch), (LAS unsigned*)(st_), 16, 0, 0); \
        __builtin_amdgcn_global_load_lds((const unsigned*)(q0_ + ZC_VB + vch), (LAS unsigned*)(st_ + 8192), 16, 0, 0); \
        __builtin_amdgcn_global_load_lds((const unsigned*)(q1_ + ZC_KB + kch), (LAS unsigned*)(st_ + 16384), 16, 0, 0); \
        __builtin_amdgcn_global_load_lds((const unsigned*)(q1_ + ZC_VB + vch), (LAS unsigned*)(st_ + 24576), 16, 0, 0); } } while (0)
#define DSA_MFRAG(dst, W0, W1, W2, W3) do { u32x4 m_ = {0u, 0u, 0u, 0u}; \
        if (h == 0) { m_.x = (__builtin_amdgcn_ubfe(~(W0), (unsigned)r32, 1u) | (__builtin_amdgcn_ubfe(~(W1), (unsigned)r32, 1u) << 16)) * 0xC700u; \
                      m_.y = (__builtin_amdgcn_ubfe(~(W2), (unsigned)r32, 1u) | (__builtin_amdgcn_ubfe(~(W3), (unsigned)r32, 1u) << 16)) * 0xC700u; } \
        dst = __builtin_bit_cast(bf16x8, m_); } while (0)
#define DSA_PAIR(p_) do { const int p = (p_); \
        LAS unsigned char* bufA = lds + (p & 1) * 32768; LAS unsigned char* bufB = bufA + 16384; \
        asm volatile("s_waitcnt vmcnt(0)" ::: "memory"); \
        __syncthreads(); \
        DSA_DMA(p + 1); \
        const u32x4 c0_ = wq0, c1_ = wq1, c2_ = wq2, c3_ = wq3; \
        if (p + 1 < npair) { wq0 = *(const u32x4*)(dmw + 4 * (p + 1)); wq1 = *(const u32x4*)(dmw + 64 + 4 * (p + 1)); wq2 = *(const u32x4*)(dmw + 128 + 4 * (p + 1)); wq3 = *(const u32x4*)(dmw + 192 + 4 * (p + 1)); } \
        bf16x8 efrag; { int lane_ = lane; asm volatile("" : "+v"(lane_)); const int tk = (lane_ & 31) >> 3; u32x4 e = {0u, 0u, 0u, 0u};   \
          if ((lane_ >> 5) == 0) { e.x = (tk == 0 ? 0x3F80u : 0u) | (tk == 1 ? 0x3F800000u : 0u); e.y = (tk == 2 ? 0x3F80u : 0u) | (tk == 3 ? 0x3F800000u : 0u); } \
          efrag = __builtin_bit_cast(bf16x8, e); } \
        bf16x8 ma0, ma1, mb0, mb1; DSA_MFRAG(ma0, c0_.x, c1_.x, c2_.x, c3_.x); DSA_MFRAG(ma1, c0_.y, c1_.y, c2_.y, c3_.y); DSA_MFRAG(mb0, c0_.z, c1_.z, c2_.z, c3_.z); DSA_MFRAG(mb1, c0_.w, c1_.w, c2_.w, c3_.w); \
        f32x16 pa0, pa1, pb0, pb1; flash_qk_bias(bufA, qf, pa0, pa1, r32, h, ma0, ma1, efrag); flash_qk_bias(bufB, qf, pb0, pb1, r32, h, mb0, mb1, efrag); \
        flash_pv2(st, sb, pa0, pa1, true, pb0, pb1, 2 * p + 1 < ntot, bufA + 8192, bufB + 8192, lane); } while (0)
    u32x4 wq0 = *(const u32x4*)(dmw), wq1 = *(const u32x4*)(dmw + 64), wq2 = *(const u32x4*)(dmw + 128), wq3 = *(const u32x4*)(dmw + 192);
    DSA_DMA(0);
    for (int p0_ = 0; p0_ < npair; ++p0_) DSA_PAIR(p0_);
#undef DSA_DMA
#undef DSA_MFRAG
#undef DSA_PAIR
    fs_merge(st, sb);
    const float lt = half_sum(st.l); const float inv = lt > 0.f ? 1.0f / lt : 0.f;
#pragma unroll
    for (int r = 0; r < 16; ++r) { st.o0[r] *= inv; st.o1[r] *= inv; }
    store_y(YB + grow * 1024 + 512 + head * 64, st.o0, st.o1, h);
    __syncthreads();
}


DI float gelu_tanh(float x) { const float u = 0.7978845608028654f * (x + 0.044715f * x * x * x); const float t = 1.0f - 2.0f / (__expf(2.0f * u) + 1.0f); return 0.5f * x * (1.0f + t); }
DI void compress_task(LAS unsigned char* lds, const bf16_t* Z, const bf16_t* W1t, const bf16_t* W2t, const float* bias1, bf16_t* KCC, bf16_t* VCT, int kv, int b, int hk, int nt4, int tid, int wave, int lane) {
    const int r32 = lane & 31, h = lane >> 5;
    const int n0 = 32 * nt4;
    const int srow = tid >> 3, sch = tid & 7;
    const bf16_t* asrc = W1t + (size_t)srow * 2048 + sch * 8;
    const int adst = srow * 128 + ((sch ^ ((srow >> 1) & 7)) << 4);
    const int nb = (n0 + srow > 126) ? 126 : n0 + srow;
    const bf16_t* bsrc = Z + ((size_t)b * SEQ + nb * 16) * NZ + (kv ? ZC_VC : ZC_KC) + hk * 64 + sch * 8;
    const bool bthr = tid < 256;
    const int aoff = (32 * wave + r32) * 128, boff = 32768 + r32 * 128, sw = (r32 >> 1) & 7;
    u32x4 a0[4], a1[4], b0v = {0u, 0u, 0u, 0u}, b1v = b0v;
#define CMP_LOAD(tk_, AR, BR) do { const int t_ = (tk_); if (t_ < 32) { _Pragma("unroll") for (int i = 0; i < 4; ++i) AR[i] = *(const u32x4*)(asrc + (size_t)i * 64 * 2048 + t_ * 64); \
        if (bthr) BR = *(const u32x4*)(bsrc + (size_t)t_ * NZ); } } while (0)
#define CMP_STEP(tk_, AR, BR, ST) do { LAS unsigned char* st_ = lds + (ST) * 36864; \
        _Pragma("unroll") for (int i = 0; i < 4; ++i) *(LAS u32x4*)(st_ + adst + i * 8192) = AR[i]; \
        if (bthr) *(LAS u32x4*)(st_ + 32768 + adst) = BR; \
        __syncthreads(); \
        CMP_LOAD((tk_) + 2, AR, BR); \
        _Pragma("unroll") for (int s = 0; s < 4; ++s) { const int co = ((2 * s + h) ^ sw) << 4; \
            const bf16x8 af = *(const LAS bf16x8*)(st_ + aoff + co); const bf16x8 bq = *(const LAS bf16x8*)(st_ + boff + co); acc = MFMA32(af, bq, acc); } } while (0)
    f32x16 acc = f16zero();
    CMP_LOAD(0, a0, b0v); CMP_LOAD(1, a1, b1v);
    for (int tk = 0; tk < 32; tk += 2) { CMP_STEP(tk, a0, b0v, 0); CMP_STEP(tk + 1, a1, b1v, 1); }
#undef CMP_LOAD
#undef CMP_STEP
    __syncthreads();
#pragma unroll
    for (int r = 0; r < 16; ++r) acc[r] = gelu_tanh(acc[r] + bias1[kv * 256 + 32 * wave + crow(r, h)]);
    f32x16 part0 = f16zero(), part1 = f16zero();
#pragma unroll
    for (int s2 = 0; s2 < 2; ++s2) {
        const bf16x8 pf = pack8(acc, s2);
#pragma unroll
        for (int dt = 0; dt < 2; ++dt) {
            const bf16_t* wp = W2t + (size_t)(32 * dt + r32) * 256 + 32 * wave + 16 * s2 + 4 * h;
            const u32x2 lo = *(const u32x2*)wp, hi = *(const u32x2*)(wp + 8);
            const u32x4 w4 = {lo.x, lo.y, hi.x, hi.y}; const bf16x8 wf = __builtin_bit_cast(bf16x8, w4);
            if (dt == 0) part0 = MFMA32(wf, pf, part0); else part1 = MFMA32(wf, pf, part1);
        }
    }
    LAS float* red = (LAS float*)lds;
#pragma unroll
    for (int r = 0; r < 16; ++r) { red[wave * 2048 + crow(r, h) * 32 + r32] = part0[r]; red[wave * 2048 + (32 + crow(r, h)) * 32 + r32] = part1[r]; }
    __syncthreads();
    const int nn = tid & 31, d4 = tid >> 5; float o[4];
#pragma unroll
    for (int e = 0; e < 4; ++e) { float s = 0.f;
#pragma unroll
        for (int w = 0; w < 8; ++w) s += red[w * 2048 + (4 * d4 + e) * 32 + nn];
        o[e] = s; }
    const int ng = n0 + nn;
    if (kv == 0) { u32x2 w; w.x = pk2(o[0], o[1]); w.y = pk2(o[2], o[3]); *(u32x2*)(KCC + ((size_t)(b * 2 + hk) * 128 + ng) * 64 + 4 * d4) = w; }
    else {
#pragma unroll
        for (int e = 0; e < 4; ++e) VCT[((size_t)(b * 2 + hk) * 64 + 4 * d4 + e) * 128 + ng] = (bf16_t)f2bf(o[e]);
    }
    __syncthreads();
}

DI void cmp_task(const bf16_t* Z, const bf16_t* KCC, const bf16_t* VCT, bf16_t* OCMP, unsigned* selm, int b, int hk, int tg, int lane) {
    const int r32 = lane & 31, h = lane >> 5;
    const int tok = 8 * tg + (r32 >> 2), g = r32 & 3, head = hk * 4 + g;
    const size_t grow = (size_t)b * SEQ + tok;
    const bf16_t* zr = Z + grow * NZ;
    bf16x8 qf[4];
#pragma unroll
    for (int s = 0; s < 4; ++s) qf[s] = *(const bf16x8*)(zr + ZC_QA + head * 64 + 16 * s + 8 * h);
    const bf16_t* kc = KCC + (size_t)(b * 2 + hk) * 128 * 64; const bf16_t* vt = VCT + (size_t)(b * 2 + hk) * 64 * 128;
    const int tmax = 8 * tg + 7;
    const int nsub = tmax < 31 ? 0 : (((tmax - 31) >> 4) >> 5) + 1;
    f32x16 p[4];
#pragma unroll
    for (int sub = 0; sub < 4; ++sub) {
        if (sub < nsub) {
            p[sub] = f16zero();
#pragma unroll
            for (int s = 0; s < 4; ++s) { const bf16x8 af = *(const bf16x8*)(kc + (size_t)(32 * sub + r32) * 64 + 16 * s + 8 * h); p[sub] = MFMA32(af, qf[s], p[sub]); }
#pragma unroll
            for (int r = 0; r < 16; ++r) { const int n = 32 * sub + crow(r, h); p[sub][r] = (16 * n + 31 <= tok) ? p[sub][r] * SM_C : NINF; }
        } else {
#pragma unroll
            for (int r = 0; r < 16; ++r) p[sub][r] = NINF;
        }
    }
    float mx = NINF;
#pragma unroll
    for (int sub = 0; sub < 4; ++sub)
#pragma unroll
        for (int r = 0; r < 16; ++r) mx = fmaxf(mx, p[sub][r]);
    mx = fmaxf(mx, __shfl_xor(mx, 32));
    const float mu = (mx == NINF) ? 0.f : mx;
    float sum = 0.f;
#pragma unroll
    for (int sub = 0; sub < 4; ++sub)
#pragma unroll
        for (int r = 0; r < 16; ++r) { p[sub][r] = fexp2(p[sub][r] - mu); sum += p[sub][r]; }
    const float lt = sum + __shfl_xor(sum, 32); const float inv = lt > 0.f ? 1.0f / lt : 0.f;
#pragma unroll
    for (int sub = 0; sub < 4; ++sub)
#pragma unroll
        for (int r = 0; r < 16; ++r) p[sub][r] *= inv;
    f32x16 o0 = f16zero(), o1 = f16zero();
#pragma unroll
    for (int sub = 0; sub < 4; ++sub) if (sub < nsub) {
#pragma unroll
        for (int s2 = 0; s2 < 2; ++s2) {
            const bf16x8 pf = pack8(p[sub], s2);
#pragma unroll
            for (int dt = 0; dt < 2; ++dt) {
                const bf16_t* wp = vt + (size_t)(32 * dt + r32) * 128 + 32 * sub + 16 * s2 + 4 * h;
                const u32x2 lo = *(const u32x2*)wp, hi = *(const u32x2*)(wp + 8);
                const u32x4 w4 = {lo.x, lo.y, hi.x, hi.y}; const bf16x8 vf = __builtin_bit_cast(bf16x8, w4);
                if (dt == 0) o0 = MFMA32(vf, pf, o0); else o1 = MFMA32(vf, pf, o1);
            }
        }
    }
    store_y(OCMP + grow * 512 + head * 64, o0, o1, h);
    const int cur = tg >> 3; unsigned mask;
    if (cur <= 7) mask = (2u << cur) - 1u;
    else {
        float a[4][4], PL[4][4];
#pragma unroll
        for (int T = 0; T < 4; ++T)
#pragma unroll
            for (int mm = 0; mm < 4; ++mm) { a[T][mm] = (p[T][4 * mm] + p[T][4 * mm + 1]) + (p[T][4 * mm + 2] + p[T][4 * mm + 3]); PL[T][mm] = __shfl_xor(p[T][4 * mm + 3], 32); }
#pragma unroll
        for (int T = 0; T < 4; ++T)
#pragma unroll
            for (int mm = 0; mm < 4; ++mm) { const float prev = mm > 0 ? PL[T][mm - 1] : (T > 0 ? PL[T - 1][3] : 0.f); a[T][mm] += h ? PL[T][mm] : prev; }
        float ev[4][4], od[4][4], mine[4];
#pragma unroll
        for (int T = 0; T < 4; ++T)
#pragma unroll
            for (int mm = 0; mm < 4; ++mm) {
                float v = a[T][mm]; v += dpp_x1(v); v += dpp_x2(v);
                const int j = 8 * T + 2 * mm + h; v = (j >= 1 && j <= cur - 2) ? v : -1.0f;
                const float vx = __shfl_xor(v, 32);
                ev[T][mm] = h ? vx : v; od[T][mm] = h ? v : vx; a[T][mm] = v;
            }
#pragma unroll
        for (int mm = 0; mm < 4; ++mm) mine[mm] = g == 0 ? a[0][mm] : g == 1 ? a[1][mm] : g == 2 ? a[2][mm] : a[3][mm];
        unsigned word = 0u;
#pragma unroll
        for (int mm = 0; mm < 4; ++mm) {
            const int jm = 8 * g + 2 * mm + h; const float v = mine[mm]; int rank = 0;
#pragma unroll
            for (int T = 0; T < 4; ++T)
#pragma unroll
                for (int m2 = 0; m2 < 4; ++m2) { const int je = 8 * T + 2 * m2;
                    rank += (ev[T][m2] > v || (ev[T][m2] == v && je < jm)) ? 1 : 0; rank += (od[T][m2] > v || (od[T][m2] == v && je + 1 < jm)) ? 1 : 0; }
            if (v >= 0.f && rank < 5) word |= 1u << jm;
        }
        word |= dpp_x1u(word); word |= dpp_x2u(word); word |= __shfl_xor(word, 32);
        mask = word | 1u | (1u << cur) | (1u << (cur - 1));
    }
    if (g == 0 && h == 0) selm[grow * 2 + hk] = mask;
}

constexpr size_t SC_PB = (size_t)64 * 64 * (32 * 33 / 2);
DI size_t sc_rowoff(int b, int t) { const int c = t >> 6; return (size_t)b * SC_PB + (size_t)4096 * (c * (c + 1) / 2) + (size_t)(t & 63) * (64 * (c + 1)); }
DI void score_range(const bf16_t* Z, float* SC, int i0, int i1, int lane) {
    const int r32 = lane & 31, h = lane >> 5;
    if (i0 >= i1) return;
    int b = i0 / 2080; const int rem = i0 - b * 2080;
    int qt = (int)((sqrtf(8.0f * (float)rem + 1.0f) - 1.0f) * 0.5f);
    while (qt * (qt + 1) / 2 > rem) --qt;
    while ((qt + 1) * (qt + 2) / 2 <= rem) ++qt;
    int sub = rem - qt * (qt + 1) / 2;
    bf16x8 qf[4][4]; float iwr[4][16]; float* sbase = nullptr; int Lrow = 0;
    bf16x8 kf[4], kn[4];
#define SCORE_LOADQ() do { const bf16_t* zq_ = Z + ((size_t)b * SEQ + 32 * qt) * NZ; \
        _Pragma("unroll") for (int hh = 0; hh < 4; ++hh) \
            _Pragma("unroll") for (int s = 0; s < 4; ++s) qf[hh][s] = *(const bf16x8*)(zq_ + (size_t)r32 * NZ + ZC_IQ + hh * 64 + 16 * s + 8 * h); \
        _Pragma("unroll") for (int r = 0; r < 16; ++r) { const u32x2 w_ = *(const u32x2*)(zq_ + (size_t)crow(r, h) * NZ + ZC_IW); \
            iwr[0][r] = bflo(w_.x) * 0.0625f; iwr[1][r] = bfhi(w_.x) * 0.0625f; iwr[2][r] = bflo(w_.y) * 0.0625f; iwr[3][r] = bfhi(w_.y) * 0.0625f; } \
        { const int c_ = qt >> 1; Lrow = 64 * (c_ + 1); sbase = SC + (size_t)b * SC_PB + (size_t)4096 * (c_ * (c_ + 1) / 2) + (size_t)((qt & 1) * 32 + 4 * h) * Lrow + r32; } } while (0)
#define SCORE_LOADK(dst, b_, sub_) do { const bf16_t* kr_ = Z + ((size_t)(b_) * SEQ + 32 * (sub_) + r32) * NZ + ZC_IK + 8 * h; \
        _Pragma("unroll") for (int s = 0; s < 4; ++s) dst[s] = *(const bf16x8*)(kr_ + 16 * s); } while (0)
    SCORE_LOADQ();
    SCORE_LOADK(kf, b, sub);
    for (int i = i0; i < i1; ++i) {
        int nb = b, nq = qt, ns = sub + 1;
        if (ns > nq) { ns = 0; ++nq; if (nq == 64) { nq = 0; ++nb; } }
        const bool more = i + 1 < i1;
        if (more) SCORE_LOADK(kn, nb, ns);
        f32x16 sc = f16zero();
#pragma unroll
        for (int hh = 0; hh < 4; ++hh) {
            f32x16 acc = f16zero();
#pragma unroll
            for (int s = 0; s < 4; ++s) acc = MFMA32(qf[hh][s], kf[s], acc);
#pragma unroll
            for (int r = 0; r < 16; ++r) sc[r] += iwr[hh][r] * fmaxf(acc[r], 0.f);
        }
#pragma unroll
        for (int r = 0; r < 16; ++r) sbase[(size_t)((r & 3) + 8 * (r >> 2)) * Lrow + 32 * sub] = sc[r];
        if (more) {
            const bool newq = (nq != qt) || (nb != b);
            b = nb; qt = nq; sub = ns;
            if (newq) SCORE_LOADQ();
#pragma unroll
            for (int s = 0; s < 4; ++s) kf[s] = kn[s];
        }
    }
#undef SCORE_LOADQ
#undef SCORE_LOADK
}

DI void select_row(const float* SC, unsigned* dmask, int b, int t, int lane) {
    unsigned* dm = dmask + ((size_t)b * SEQ + t) * 64;
    const int nvalid = t + 1;
    if (nvalid <= 256) {
        const int w = lane;
        const int lo = 32 * w; unsigned bits = 0u;
        if (lo + 31 <= t) bits = 0xffffffffu; else if (lo <= t) bits = (2u << (t - lo)) - 1u;
        dm[w] = bits; return;
    }
    const int nch = (nvalid + 255) >> 8;
    const float* srow = SC + sc_rowoff(b, t) + 4 * lane;
    unsigned u[8][4];
#pragma unroll
    for (int k = 0; k < 8; ++k) {
        if (k < nch) {
            const f32x4 v = *(const f32x4*)(srow + 256 * k);
#pragma unroll
            for (int e = 0; e < 4; ++e) { const unsigned bits = __builtin_bit_cast(unsigned, v[e] + 0.0f); const unsigned key = ((int)bits < 0) ? ~bits : (bits | 0x80000000u);
                u[k][e] = (256 * k + 4 * lane + e <= t) ? key : 0u; }
        } else { u[k][0] = 0u; u[k][1] = 0u; u[k][2] = 0u; u[k][3] = 0u; }
    }
#define SEL_COUNT(cand_, cnt_) do { unsigned cl_ = 0u; const unsigned cs_ = (cand_); \
        _Pragma("unroll") for (int k2 = 0; k2 < 4; ++k2) if (2 * k2 < nch) { \
            _Pragma("unroll") for (int q = 0; q < 8; ++q) asm("v_cmp_le_u32_e32 vcc, %2, %1\n\tv_addc_co_u32_e32 %0, vcc, 0, %0, vcc" : "+v"(cl_) : "v"(u[2 * k2 + (q >> 2)][q & 3]), "s"(cs_) : "vcc"); } \
        int v_ = (int)cl_;        \
        v_ += __builtin_amdgcn_update_dpp(0, v_, 0x111, 0xf, 0xf, false); \
        v_ += __builtin_amdgcn_update_dpp(0, v_, 0x112, 0xf, 0xf, false); \
        v_ += __builtin_amdgcn_update_dpp(0, v_, 0x114, 0xf, 0xf, false); \
        v_ += __builtin_amdgcn_update_dpp(0, v_, 0x118, 0xf, 0xf, false); \
        v_ += __builtin_amdgcn_update_dpp(0, v_, 0x142, 0xa, 0xf, false); \
        v_ += __builtin_amdgcn_update_dpp(0, v_, 0x143, 0xc, 0xf, false); \
        cnt_ = __builtin_amdgcn_readlane(v_, 63); } while (0)
    unsigned T = 0u; bool hit = false; int startbit = 31;
    {
        int cnt; SEL_COUNT(0xC0000000u, cnt);
        if (cnt < 256) {
#pragma unroll 1
            for (unsigned e = 0x7Fu; e >= 0x7Bu; --e) {
                const unsigned cand = 0x80000000u | (e << 23); SEL_COUNT(cand, cnt);
                if (cnt >= 256) { T = cand; startbit = 22; hit = (cnt == 256); break; }
            }
        }
    }
    if (!hit) {
        for (int bit = startbit; bit >= 0; --bit) {
            const unsigned cand = T | (1u << bit); int cnt; SEL_COUNT(cand, cnt);
            if (cnt >= 256) { T = cand; if (cnt == 256) { hit = true; break; } }
        }
    }
#undef SEL_COUNT
    int cgt = 0, cge = 256;
    if (!hit) { cge = 0;
#pragma unroll
    for (int k = 0; k < 8; ++k) if (k < nch) {
#pragma unroll
        for (int e = 0; e < 4; ++e) { cgt += __popcll(__ballot(u[k][e] > T)); cge += __popcll(__ballot(u[k][e] >= T)); }
    }
    }
    const int need = 256 - cgt;
    const bool exact = (cge == 256);
    int tie_before = 0;
    const unsigned long long ltmask = (1ull << lane) - 1ull;
#pragma unroll
    for (int k = 0; k < 8; ++k) {
        unsigned nib = 0u;
        if (k < nch) {
            if (exact) {
#pragma unroll
                for (int e = 0; e < 4; ++e) nib |= (u[k][e] >= T ? 1u : 0u) << e;
            } else {
                unsigned long long bm[4]; int lanes_before = 0, tot = 0;
#pragma unroll
                for (int e = 0; e < 4; ++e) { bm[e] = __ballot(u[k][e] == T); lanes_before += __popcll(bm[e] & ltmask); tot += __popcll(bm[e]); }
                int rank = tie_before + lanes_before;
#pragma unroll
                for (int e = 0; e < 4; ++e) { const bool eq = (u[k][e] == T); const bool s = (u[k][e] > T) || (eq && rank < need); nib |= (s ? 1u : 0u) << e; rank += eq ? 1 : 0; }
                tie_before += tot;
            }
        }
        unsigned val = nib << (4 * (lane & 7));
        val |= (unsigned)__builtin_amdgcn_update_dpp(0, (int)val, 0x101, 0xf, 0xf, true); val |= (unsigned)__builtin_amdgcn_update_dpp(0, (int)val, 0x102, 0xf, 0xf, true); val |= (unsigned)__builtin_amdgcn_update_dpp(0, (int)val, 0x104, 0xf, 0xf, true);
        if ((lane & 7) == 0) dm[8 * k + (lane >> 3)] = val;
    }
}

struct MapIdent { DI int operator()(int d, int& sel) const { sel = 0; return d; } };
struct MapInProj {
    DI int operator()(int c, int& sel) const {
        sel = 0;
        if (c < 1792) {
            const int hb = c >> 6, g = c & 63, w = g >> 5, fq = (g >> 3) & 3, n = (g >> 2) & 1, i = g & 3, d = 32 * n + 16 * w + 4 * fq + i;
            int base;
            if (hb < 8) base = 0 + 64 * hb; else if (hb < 10) base = 512 + 64 * (hb - 8); else if (hb < 12) base = 768 + 64 * (hb - 10); else if (hb < 14) base = 1024 + 64 * (hb - 12);
            else if (hb < 22) base = 1304 + 64 * (hb - 14); else if (hb < 23) base = 1816; else if (hb < 27) base = 1944 + 64 * (hb - 23); else base = 2200;
            return base + d;
        }
        if (c < 1920) return 640 + (c - 1792);
        if (c < 2048) return 896 + (c - 1920);
        if (c < 2176) return 1152 + (c - 2048);
        if (c < 2240) return 1880 + (c - 2176);
        if (c < 2264) return 1280 + (c - 2240);
        if (c < 2268) return 2264 + (c - 2264);
        if (c < 2304) return -1;
        return 2268 + (c - 2304);
    }
};
struct MapGU {
    DI int operator()(int c, int& sel) const {
        sel = (c >> 2) & 1;
        return 128 * (c >> 8) + 64 * ((c >> 7) & 1) + 16 * ((c >> 5) & 3) + 4 * ((c >> 3) & 3) + (c & 3);
    }
};
template <class Map>
DI void transpose_item(const float* W0, const float* W1, int N, int K, int Nd, const float* kscale, bf16_t* WT, Map map, LAS float* scr, int it, int lane, int ldk = 0, int koff = 0) {
    if (ldk == 0) ldk = K;
    const int nblk = Nd / 32;
    const int kb = it / nblk, db = it % nblk, k0 = 64 * kb, d0 = 32 * db;
    int sel; const int col = map(d0 + (lane & 31), sel);
    const float* W = sel ? W1 : W0;
    float v[32];
#pragma unroll
    for (int i = 0; i < 32; ++i) { const int kk = 2 * i + (lane >> 5); v[i] = (col >= 0) ? W[(size_t)(k0 + kk) * N + col] : 0.f; }
    if (kscale) {
#pragma unroll
        for (int i = 0; i < 32; ++i) v[i] *= kscale[k0 + 2 * i + (lane >> 5)];
    }
#pragma unroll
    for (int i = 0; i < 32; ++i) scr[(2 * i + (lane >> 5)) * 33 + (lane & 31)] = v[i];
    asm volatile("s_waitcnt lgkmcnt(0)" ::: "memory");
    const int c = lane & 7;
#pragma unroll
    for (int j = 0; j < 4; ++j) { const int n = (lane >> 3) + 8 * j; const LAS float* s = scr + (8 * c) * 33 + n;
        u32x4 o; o.x = pk2(s[0 * 33], s[1 * 33]); o.y = pk2(s[2 * 33], s[3 * 33]); o.z = pk2(s[4 * 33], s[5 * 33]); o.w = pk2(s[6 * 33], s[7 * 33]);
        *(u32x4*)(WT + (size_t)(d0 + n) * ldk + koff + k0 + 8 * c) = o; }
    asm volatile("s_waitcnt lgkmcnt(0)" ::: "memory");
}

struct Args { const float* in[17]; float* out; unsigned char* ws; };

__global__ void __launch_bounds__(NTHR, 2) fwd_kernel(Args a) {
    extern __shared__ __attribute__((aligned(16))) unsigned char lds_raw[];
    LAS unsigned char* lds = (LAS unsigned char*)lds_raw;
    const int tid = threadIdx.x, lane = tid & 63, wave = __builtin_amdgcn_readfirstlane(tid >> 6);
    const int G = gridDim.x, gw = blockIdx.x * NWAVES + wave, NGW = G * NWAVES;
    volatile LAS unsigned* lctl = (volatile LAS unsigned*)(lds + 131072);
    if (tid < 4) lctl[tid] = 0u;
    __syncthreads();
    XcdBarrier xbar = xcd_barrier_post((unsigned*)(a.ws + WS_CTL), lctl);
    unsigned char* ws = a.ws;
    const float* x = a.in[0];
    bf16_t* Win_t = (bf16_t*)(ws + WS_WIN); bf16_t* W1k_t = (bf16_t*)(ws + WS_W1K); bf16_t* W1v_t = (bf16_t*)(ws + WS_W1V);
    bf16_t* W2k_t = (bf16_t*)(ws + WS_W2K); bf16_t* W2v_t = (bf16_t*)(ws + WS_W2V); float* bias1 = (float*)(ws + WS_BIAS1);
    float* ropec = (float*)(ws + WS_ROPE); float* ropes = ropec + SEQ * 32;
    bf16_t* Wba_t = (bf16_t*)(ws + WS_WBA); bf16_t* Wbb_t = (bf16_t*)(ws + WS_WBB); bf16_t* Wo_t = (bf16_t*)(ws + WS_WO);
    bf16_t* Wgu_t = (bf16_t*)(ws + WS_WGU); bf16_t* Wd_t = (bf16_t*)(ws + WS_WD);
    bf16_t* XN = (bf16_t*)(ws + WS_XN); bf16_t* Z = (bf16_t*)(ws + WS_Z); bf16_t* ACT = (bf16_t*)(ws + WS_ACT);
    bf16_t* T1 = (bf16_t*)(ws + WS_T1); bf16_t* MG = (bf16_t*)(ws + WS_MG); bf16_t* HB = (bf16_t*)(ws + WS_HB);
    float* SS1 = (float*)(ws + WS_SS1); float* SS2 = (float*)(ws + WS_SS2);
    unsigned char* os = (unsigned char*)a.out;
    bf16_t* YA = (bf16_t*)(os + OS_YA); bf16_t* YB = YA;
    bf16_t* OCMP = (bf16_t*)(os + OS_OCMP); unsigned* DMASK = (unsigned*)(os + OS_DMASK); unsigned* SELM = (unsigned*)(os + OS_SELM);
    float* SC = (float*)(ws + WS_SC); bf16_t* KCC = (bf16_t*)(ws + WS_KCC); bf16_t* VCT = (bf16_t*)(ws + WS_VCT);
    unsigned* TASKTAB = (unsigned*)(ws + WS_BIAS1 + 4096);
    float* BPART = (float*)(ws + WS_BIAS1 + 16384);

#ifndef REP_P0
#define REP_P0 1
#endif
#ifndef REP_P1
#define REP_P1 1
#endif
#ifndef REP_P7
#define REP_P7 1
#endif
    for (int rep = 0; rep < REP_P0; ++rep) {
        LAS float* scr = (LAS float*)(lds + wave * 16384);
        {
            constexpr int I0 = (DM / 64) * (NZ / 32), I1 = 32 * 8, I3 = 4 * 2;
            constexpr int NIT = I0 + 2 * I1 + 2 * I3;
            for (int it0 = gw; it0 < NIT; it0 += NGW) {
                int r = it0;
                if (r < I0) { transpose_item(a.in[2], a.in[2], DIN, DM, NZ, nullptr, Win_t, MapInProj(), scr, r, lane); continue; } r -= I0;
                if (r < I1) { transpose_item(a.in[4], a.in[4], 256, 2048, 256, nullptr, W1k_t, MapIdent(), scr, r, lane); continue; } r -= I1;
                if (r < I1) { transpose_item(a.in[7], a.in[7], 256, 2048, 256, nullptr, W1v_t, MapIdent(), scr, r, lane); continue; } r -= I1;
                if (r < I3) { transpose_item(a.in[5], a.in[5], 64, 256, 64, nullptr, W2k_t, MapIdent(), scr, r, lane); continue; } r -= I3;
                transpose_item(a.in[8], a.in[8], 64, 256, 64, nullptr, W2v_t, MapIdent(), scr, r, lane);
            }
        }
        const float* gmix = a.in[1];
        for (int m = gw; m < MTOK; m += 4 * NGW) {
            f32x4 v[4][4]; float s[4];
#pragma unroll
            for (int q = 0; q < 4; ++q) { const int mq = (m + q * NGW < MTOK) ? m + q * NGW : m; const f32x4* xr = (const f32x4*)(x + (size_t)mq * DM) + lane;
#pragma unroll
                for (int j = 0; j < 4; ++j) v[q][j] = xr[64 * j]; }
#pragma unroll
            for (int q = 0; q < 4; ++q) { s[q] = 0.f;
#pragma unroll
                for (int j = 0; j < 4; ++j) s[q] += (v[q][j][0] * v[q][j][0] + v[q][j][1] * v[q][j][1]) + (v[q][j][2] * v[q][j][2] + v[q][j][3] * v[q][j][3]); }
#pragma unroll
            for (int o = 1; o < 64; o <<= 1) {
#pragma unroll
                for (int q = 0; q < 4; ++q) s[q] += __shfl_xor(s[q], o); }
            const f32x4* gr = (const f32x4*)gmix + lane;
#pragma unroll
            for (int q = 0; q < 4; ++q) if (m + q * NGW < MTOK) {
                const float rr = 1.0f / sqrtf(s[q] * (1.0f / DM) + EPS);
                u32x2* o8 = (u32x2*)(XN + (size_t)(m + q * NGW) * DM) + lane;
#pragma unroll
                for (int j = 0; j < 4; ++j) { const f32x4 g = gr[64 * j]; u32x2 w; w.x = pk2(v[q][j][0] * rr * g[0], v[q][j][1] * rr * g[1]); w.y = pk2(v[q][j][2] * rr * g[2], v[q][j][3] * rr * g[3]); o8[64 * j] = w; }
            }
        }
        for (int i = blockIdx.x * NTHR + tid; i < SEQ * 32; i += G * NTHR) {
            const int pos = i >> 5, j = i & 31; const float inv = powf(10000.0f, -(float)j / 32.0f); const float ang = (float)pos * inv;
            ropec[i] = cosf(ang); ropes[i] = sinf(ang);
        }
        for (int o = NGW - 1 - gw; o < 256; o += NGW) {
            const int kv = o >> 7, jb = (o >> 5) & 3, kc = o & 31; const float* pos = a.in[kv ? 6 : 3]; const float* w1 = a.in[kv ? 7 : 4]; float s = 0.f;
#pragma unroll 8
            for (int k = 0; k < 64; ++k) s += pos[kc * 64 + k] * w1[(size_t)(kc * 64 + k) * 256 + jb * 64 + lane];
            BPART[kc * 512 + kv * 256 + jb * 64 + lane] = s;
        }
        if (gw == NGW - 1 - 256 || (NGW <= 256 && gw == 0)) {
            for (int k = lane; k < 96; k += 64) {
                const int cost = k < 32 ? 7 * ((k + 1) + (k + 1 < 9 ? k + 1 : 9)) : 6 * (((k - 32) >> 1) + 1), cnt = k < 32 ? 32 : 16; int pos = 0;
                for (int k2 = 0; k2 < 96; ++k2) { const int c2 = k2 < 32 ? 7 * ((k2 + 1) + (k2 + 1 < 9 ? k2 + 1 : 9)) : 6 * (((k2 - 32) >> 1) + 1), n2 = k2 < 32 ? 32 : 16;
                    if (c2 > cost || (c2 == cost && k2 < k)) pos += n2; }
                for (int bb = 0; bb < cnt; ++bb) TASKTAB[pos + bb] = (unsigned)k | ((unsigned)bb << 8);
            }
        }
    }
    xcd_barrier(xbar);
    if (blockIdx.x == 0) { float s = 0.f; for (int kc = 0; kc < 32; ++kc) s += BPART[kc * 512 + tid]; bias1[tid] = s; }
    for (int rep = 0; rep < REP_P1; ++rep) { pg8::Gemm g{XN, Win_t, MTOK, NZ, DM}; pg8::StaticOrder S; S.init(MTOK, NZ, G, (int)blockIdx.x); EpiInProj E{Z, ropec, ropes}; pg8::gemm_phase(lds, g, S, E); }
    {
        const int nunits = (MTOK / 256) * (NZ / 256), rem = nunits % G;
        const int nhelp = rem ? G - rem : G, hid = rem ? (int)blockIdx.x - rem : (int)blockIdx.x;
        if (hid >= 0) {
            LAS float* scr = (LAS float*)(lds + wave * 16384);
            constexpr int I5 = 8 * 32, I7 = 16 * 32, I8 = 16 * (NGU / 32), I9 = (DFF / 64) * 32;
            constexpr int NIT2 = 2 * I5 + I7 + I8 + I9;
            for (int it0 = hid * NWAVES + wave; it0 < NIT2; it0 += nhelp * NWAVES) {
                int r = it0;
                if (r < I8) { transpose_item(a.in[13], a.in[14], DFF, DM, NGU, a.in[12], Wgu_t, MapGU(), scr, r, lane); continue; } r -= I8;
                if (r < I9) { transpose_item(a.in[15], a.in[15], DM, DFF, DM, nullptr, Wd_t, MapIdent(), scr, r, lane); continue; } r -= I9;
                if (r < I7) { transpose_item(a.in[11], a.in[11], DM, DM, DM, nullptr, Wo_t, MapIdent(), scr, r, lane); continue; } r -= I7;
                if (r < I5) { transpose_item(a.in[9], a.in[9], DM, 512, DM, nullptr, Wba_t, MapIdent(), scr, r, lane, 1024, 0); continue; } r -= I5;
                transpose_item(a.in[10], a.in[10], DM, 512, DM, nullptr, Wba_t, MapIdent(), scr, r, lane, 1024, 512);
            }
        }
    }
    xcd_barrier(xbar);
#ifndef REP_P2
#define REP_P2 1
#endif
#define REP_P2A 1
#define REP_P2B 1
#define REP_P3A 1
#define REP_P3B 1
#ifndef REP_P3
#define REP_P3 1
#endif
    for (int rep = 0; rep < REP_P2; ++rep) {
    for (int rp = 0; rp < REP_P2A; ++rp)
    if (EN_SLC || EN_CMP) for (int task = blockIdx.x; task < 256; task += G) { const int kv = task >> 7;
        compress_task(lds, Z, kv ? W1v_t : W1k_t, kv ? W2v_t : W2k_t, bias1, KCC, VCT, kv, (task >> 3) & 15, (task >> 2) & 1, task & 3, tid, wave, lane); }
    for (int rp = 0; rp < REP_P2B; ++rp)
    if (EN_DSA) { const int per = (33280 + NGW - 1) / NGW; const int i0 = gw * per, i1 = (i0 + per < 33280) ? i0 + per : 33280; score_range(Z, SC, i0, i1, lane); }
    }
    xcd_barrier(xbar);
    {
        const int nrow = (MTOK - gw + NGW - 1) / NGW, ncmp = (8192 - gw + NGW - 1) / NGW;
        const int stride = nrow > 0 && ncmp > 0 ? (nrow / ncmp > 0 ? nrow / ncmp : 1) : 1, phase = ((wave >> 2) * (stride >> 1) + (wave & 1)) % stride;
        int ci = 0;
        for (int i = 0; i < nrow || ci < ncmp; ++i) {
            if (ci < ncmp && (i >= nrow || (i % stride) == phase)) { const int task = gw + ci * NGW; ++ci;
                cmp_task(Z, KCC, VCT, OCMP, SELM, task >> 9, (task >> 8) & 1, (task + 64 * (task >> 11)) & 255, lane); }
            if (i < nrow) { const int r = gw + i * NGW; select_row(SC, DMASK, r & 15, r >> 4, lane); }
        }
    }
    xcd_barrier(xbar);
#ifndef REP_P4
#define REP_P4 1
#endif
    for (int rep = 0; rep < REP_P4; ++rep)
    for (int r = 0; r * G < 2048; ++r) {
        const int idx = r * G + ((r & 1) ? G - 1 - (int)blockIdx.x : (int)blockIdx.x);
        if (idx >= 2048) continue;
        const unsigned e = TASKTAB[idx]; const int k = (int)(e & 255u), bb = (int)(e >> 8);
        int tid_ = threadIdx.x; asm volatile("" : "+v"(tid_));
        const int lane_ = tid_ & 63;
        if (k < 32) { if (EN_WIN || EN_SLC || EN_CMP) nsa_task(lds, Z, SELM, OCMP, YA, bb >> 1, bb & 1, k, tid_, wave, lane_); }
        else { if (EN_DSA) dsa_task(lds, Z, DMASK, YB, bb, k - 32, tid_, wave, lane_); }
    }
    xcd_barrier(xbar);
    { pg8::Gemm g{YA, Wba_t, MTOK, DM, DM}; pg8::StaticOrder S; S.init(MTOK, DM, G, (int)blockIdx.x); EpiMerge E{Z, MG}; pg8::gemm_phase<EpiMerge, true>(lds, g, S, E); }
    xcd_barrier(xbar);
    { pg8::Gemm g{MG, Wo_t, MTOK, DM, DM}; pg8::StaticOrder S; S.init(MTOK, DM, G, (int)blockIdx.x); EpiResid<1> E{x, nullptr, nullptr, HB, SS1}; pg8::gemm_phase(lds, g, S, E); }
    xcd_barrier(xbar);
    for (int rep = 0; rep < REP_P7; ++rep) { pg8::Gemm g{HB, Wgu_t, MTOK, NGU, DM}; pg8::StaticOrder S; S.init(MTOK, NGU, G, (int)blockIdx.x); EpiGU E{SS1, ACT}; pg8::gemm_phase(lds, g, S, E); }
    xcd_barrier(xbar);
    { pg8::Gemm g{ACT, Wd_t, MTOK, DM, DFF}; pg8::StaticOrder S; S.init(MTOK, DM, G, (int)blockIdx.x);
      EpiDownNorm E{HB, a.out, a.in[16], (unsigned*)SS2, (unsigned*)(a.ws + WS_CTL) + 4096, lds + 131072 + 256}; pg8::gemm_phase(lds, g, S, E); }
}

extern "C" void kernel_launch(void* const* d_in, const int* in_sizes, int n_in, void* d_out, int out_size, void* d_ws, size_t ws_size, hipStream_t stream) {
    static int grid = 0;
    if (grid == 0) {
        int dev = 0, cus = 0, per_cu = 0;
        hipGetDevice(&dev);
        hipDeviceGetAttribute(&cus, hipDeviceAttributeMultiprocessorCount, dev);
        hipFuncSetAttribute((const void*)fwd_kernel, hipFuncAttributeMaxDynamicSharedMemorySize, LDS_BYTES);
        hipOccupancyMaxActiveBlocksPerMultiprocessor(&per_cu, (const void*)fwd_kernel, NTHR, LDS_BYTES);
        if (per_cu < 1) { fprintf(stderr, "occupancy query says %d\n", per_cu); per_cu = 1; }
        if (per_cu > 1) per_cu = 1;
        grid = cus * per_cu;
        if (n_in != 17 || ws_size < WS_END) { fprintf(stderr, "unexpected n_in %d / ws_size %zu\n", n_in, ws_size); }
    }
    hipMemsetAsync((char*)d_ws + WS_CTL, 0, 65536, stream);
    Args a{};
    for (int i = 0; i < 17; ++i) a.in[i] = (const float*)d_in[i];
    a.out = (float*)d_out; a.ws = (unsigned char*)d_ws;
    void* args[] = {&a};
    hipError_t e = hipLaunchCooperativeKernel((const void*)fwd_kernel, dim3(grid), dim3(NTHR), args, LDS_BYTES, stream);
    if (e != hipSuccess) fprintf(stderr, "cooperative launch failed: %s (grid %d)\n", hipGetErrorString(e), grid);
}
```
